# Optimizing an MI355X kernel written in HIP

```python
import math
import jax, jax.numpy as jnp
from jax import lax
import numpy as np

D_MODEL = 2048
BATCH = 1
SEQ = 8192
DEPTH = 4

D_FF = 5632
MLA_HEADS = 16
MLA_Q_RANK = 512
MLA_KV_RANK = 512
MLA_NOPE = 128
MLA_ROPE = 64
MLA_QK = MLA_NOPE + MLA_ROPE
MLA_V = 128
ROPE_THETA = 10000.0
Q_BLOCK = 128
SWA_Q_HEADS = 32
SWA_KV_HEADS = 8
SWA_GROUP = SWA_Q_HEADS // SWA_KV_HEADS
SWA_HEAD_DIM = 64
WINDOW = 128
BAND_BLOCK = 128
SWA_QKV = (SWA_Q_HEADS + 2 * SWA_KV_HEADS) * SWA_HEAD_DIM
N_MIXERS = 2
N_MLA_LAYERS = (DEPTH + 1) // 2
N_SWA_LAYERS = DEPTH // 2
EPS = 1e-6
NEG_INF = -1e30

kernel_name = "hybrid_mla_swa_macaron_encoder"


def rms_norm(x, g):
    xf = x.astype(jnp.float32)
    y = xf * lax.rsqrt(jnp.mean(xf * xf, axis=-1, keepdims=True) + EPS)
    return (y * g.astype(jnp.float32)).astype(x.dtype)


def swiglu(x, w_gate, w_up, w_down):
    return (jax.nn.silu(x @ w_gate) * (x @ w_up)) @ w_down


def rope_tables(positions):
    inv_freq = 1.0 / (ROPE_THETA ** (jnp.arange(0, MLA_ROPE, 2, dtype=jnp.float32) / MLA_ROPE))
    ang = positions.astype(jnp.float32)[..., None] * inv_freq
    return jnp.cos(ang), jnp.sin(ang)


def apply_rope(x, cos, sin):
    xf = x.astype(jnp.float32)
    x1, x2 = jnp.split(xf, 2, axis=-1)
    c = cos[:, :, None, :]
    s = sin[:, :, None, :]
    return jnp.concatenate([x1 * c - x2 * s, x2 * c + x1 * s], axis=-1).astype(x.dtype)


def alibi_slopes(n_heads):
    return jnp.asarray(2.0 ** (-8.0 * np.arange(1, n_heads + 1) / n_heads), dtype=jnp.float32)


def mla_mixer(x, cos, sin, w_a, q_a_g, kv_a_g, w_uq, w_ukv, q_g, k_g, w_o):
    B, S, _ = x.shape
    H = MLA_HEADS
    h = x @ w_a
    c_q = h[..., :MLA_Q_RANK]
    c_kv = h[..., MLA_Q_RANK:MLA_Q_RANK + MLA_KV_RANK]
    k_pe = h[..., MLA_Q_RANK + MLA_KV_RANK:]
    q = (rms_norm(c_q, q_a_g) @ w_uq).reshape(B, S, H, MLA_QK)
    kv = (rms_norm(c_kv, kv_a_g) @ w_ukv).reshape(B, S, H, MLA_NOPE + MLA_V)
    k_nope, v = kv[..., :MLA_NOPE], kv[..., MLA_NOPE:]
    k = jnp.concatenate([k_nope, jnp.broadcast_to(k_pe[:, :, None, :], (B, S, H, MLA_ROPE))], axis=-1)
    q = rms_norm(q, q_g)
    k = rms_norm(k, k_g)
    q = jnp.concatenate([q[..., :MLA_NOPE], apply_rope(q[..., MLA_NOPE:], cos, sin)], axis=-1)
    k = jnp.concatenate([k[..., :MLA_NOPE], apply_rope(k[..., MLA_NOPE:], cos, sin)], axis=-1)
    scale = 1.0 / math.sqrt(MLA_QK)
    nb = S // Q_BLOCK
    qb = q.reshape(B, nb, Q_BLOCK, H, MLA_QK).transpose(1, 0, 2, 3, 4)

    def block(qi):
        s = jnp.einsum('bqhd,bkhd->bhqk', qi, k).astype(jnp.float32) * scale
        p = jax.nn.softmax(s, axis=-1).astype(v.dtype)
        return jnp.einsum('bhqk,bkhd->bqhd', p, v)

    o = lax.map(block, qb)
    o = o.transpose(1, 0, 2, 3, 4).reshape(B, S, H * MLA_V)
    return o @ w_o


def band(t, nb):
    pad = [(0, 0), (BAND_BLOCK, BAND_BLOCK)] + [(0, 0)] * (t.ndim - 2)
    tp = jnp.pad(t, pad).reshape((t.shape[0], nb + 2, BAND_BLOCK) + t.shape[2:])
    return jnp.concatenate([tp[:, 0:nb], tp[:, 1:nb + 1], tp[:, 2:nb + 2]], axis=2)


def swa_mixer(x, positions, w_qkv, q_g, k_g, sink, w_o):
    B, S, _ = x.shape
    KV, G, Dh, W = SWA_KV_HEADS, SWA_GROUP, SWA_HEAD_DIM, BAND_BLOCK
    nb = S // W
    qkv = x @ w_qkv
    q = qkv[..., :SWA_Q_HEADS * Dh].reshape(B, S, KV, G, Dh)
    k = qkv[..., SWA_Q_HEADS * Dh:(SWA_Q_HEADS + KV) * Dh].reshape(B, S, KV, Dh)
    v = qkv[..., (SWA_Q_HEADS + KV) * Dh:].reshape(B, S, KV, Dh)
    q = rms_norm(q, q_g).reshape(B, nb, W, KV, G, Dh)
    k = rms_norm(k, k_g)
    kb = band(k, nb)
    vb = band(v, nb)
    pos_q = positions.reshape(B, nb, W).astype(jnp.float32)
    pos_k = band(positions, nb).astype(jnp.float32)
    valid = band(jnp.ones((1, S), dtype=bool), nb)[0]
    rel = jnp.arange(3 * W)[None, :] - W - jnp.arange(W)[:, None]
    mask = (jnp.abs(rel) <= WINDOW)[None] & valid[:, None, :]
    dist = jnp.abs(pos_q[..., :, None] - pos_k[..., None, :])
    slopes = alibi_slopes(SWA_Q_HEADS).reshape(KV, G)
    s = jnp.einsum('bnqkgd,bnskd->bnkgqs', q, kb).astype(jnp.float32) / math.sqrt(Dh)
    s = s - slopes[None, None, :, :, None, None] * dist[:, :, None, None]
    s = jnp.where(mask[None, :, None, None], s, NEG_INF)
    snk = sink.astype(jnp.float32).reshape(KV, G)[None, None, :, :, None, None]
    m = jnp.maximum(jnp.max(s, axis=-1, keepdims=True), snk)
    p = jnp.exp(s - m)
    p = p / (jnp.sum(p, axis=-1, keepdims=True) + jnp.exp(snk - m))
    o = jnp.einsum('bnkgqs,bnskd->bnqkgd', p.astype(vb.dtype), vb)
    return o.reshape(B, S, SWA_Q_HEADS * Dh) @ w_o


def setup_inputs(seed: int = 0) -> dict:
    key = jax.random.key(seed)
    ks = jax.random.split(key, 24)
    f32 = jnp.float32

    def nrm(k, shape, fan_in):
        return jax.random.normal(k, shape, f32) * (fan_in ** -0.5)

    def gain(k, shape):
        return 1.0 + 0.02 * jax.random.normal(k, shape, f32)

    x = jax.random.normal(ks[0], (BATCH, SEQ, D_MODEL), f32)
    positions = (jnp.arange(SEQ, dtype=jnp.int32)[None, :]
                 + jax.random.randint(ks[1], (BATCH, 1), 0, 1024, dtype=jnp.int32))
    L = N_MLA_LAYERS
    Ls = N_SWA_LAYERS
    return {
        "x": x,
        "positions": positions,
        "norm_g": gain(ks[2], (DEPTH, 3, D_MODEL)),
        "ffn_w_gate": nrm(ks[3], (DEPTH, 2, D_MODEL, D_FF), D_MODEL),
        "ffn_w_up": nrm(ks[4], (DEPTH, 2, D_MODEL, D_FF), D_MODEL),
        "ffn_w_down": nrm(ks[5], (DEPTH, 2, D_FF, D_MODEL), D_FF),
        "mla_w_a": nrm(ks[6], (L, D_MODEL, MLA_Q_RANK + MLA_KV_RANK + MLA_ROPE), D_MODEL),
        "mla_q_a_g": gain(ks[7], (L, MLA_Q_RANK)),
        "mla_kv_a_g": gain(ks[8], (L, MLA_KV_RANK)),
        "mla_w_uq": nrm(ks[9], (L, MLA_Q_RANK, MLA_HEADS * MLA_QK), MLA_Q_RANK),
        "mla_w_ukv": nrm(ks[10], (L, MLA_KV_RANK, MLA_HEADS * (MLA_NOPE + MLA_V)), MLA_KV_RANK),
        "mla_q_g": gain(ks[11], (L, MLA_QK)),
        "mla_k_g": gain(ks[12], (L, MLA_QK)),
        "mla_w_o": nrm(ks[13], (L, MLA_HEADS * MLA_V, D_MODEL), MLA_HEADS * MLA_V),
        "swa_w_qkv": nrm(ks[14], (Ls, D_MODEL, SWA_QKV), D_MODEL),
        "swa_q_g": gain(ks[15], (Ls, SWA_HEAD_DIM)),
        "swa_k_g": gain(ks[16], (Ls, SWA_HEAD_DIM)),
        "swa_sink": 0.5 * jax.random.normal(ks[17], (Ls, SWA_Q_HEADS), f32),
        "swa_w_o": nrm(ks[18], (Ls, SWA_Q_HEADS * SWA_HEAD_DIM, D_MODEL), SWA_Q_HEADS * SWA_HEAD_DIM),
    }


def reference(x, positions, norm_g, ffn_w_gate, ffn_w_up, ffn_w_down,
              mla_w_a, mla_q_a_g, mla_kv_a_g, mla_w_uq, mla_w_ukv, mla_q_g, mla_k_g, mla_w_o,
              swa_w_qkv, swa_q_g, swa_k_g, swa_sink, swa_w_o):
    cos, sin = rope_tables(positions)
    for i in range(DEPTH):
        g = norm_g[i]
        x = x + 0.5 * swiglu(rms_norm(x, g[0]), ffn_w_gate[i, 0], ffn_w_up[i, 0], ffn_w_down[i, 0])
        h = rms_norm(x, g[1])
        j = i // N_MIXERS
        if i % N_MIXERS == 0:
            x = x + mla_mixer(h, cos, sin, mla_w_a[j], mla_q_a_g[j], mla_kv_a_g[j],
                              mla_w_uq[j], mla_w_ukv[j], mla_q_g[j], mla_k_g[j], mla_w_o[j])
        else:
            x = x + swa_mixer(h, positions, swa_w_qkv[j], swa_q_g[j], swa_k_g[j],
                              swa_sink[j], swa_w_o[j])
        x = x + 0.5 * swiglu(rms_norm(x, g[2]), ffn_w_gate[i, 1], ffn_w_up[i, 1], ffn_w_down[i, 1])
    return x
```

```cpp
#include <hip/hip_runtime.h>
#include <cstdio>
#include <cstdint>
namespace pg8 {
#define PG8_LAS __attribute__((address_space(3)))
typedef unsigned short bf16_t;
typedef short bf16x8 __attribute__((ext_vector_type(8)));
typedef float f32x4 __attribute__((ext_vector_type(4)));
typedef unsigned u32x4 __attribute__((ext_vector_type(4)));
constexpr int BM = 256, BK = 64, HALF = 128, HTB = HALF * BK * 2  , STAGE_BYTES = 8 * HTB, NXCD = 8, WGM = 8;

__host__ __device__ __forceinline__ int lds_byte(int r, int c) { const int st = (r >> 4) * 2 + (c >> 5), rr = r & 15, cc = c & 31, ob = rr * 64 + cc * 2; return st * 1024 + (ob ^ (((ob >> 9) & 1) << 5)); }
__host__ __device__ __forceinline__ void stage_rc(int b, int& R, int& C) { const int st = b / 1024, sb = b % 1024, swz = sb ^ (((sb >> 9) & 1) << 5); R = (st >> 1) * 16 + swz / 64; C = (st & 1) * 32 + (swz % 64) / 2; }
__host__ __device__ __forceinline__ int perm32(int rho) { const int n = rho >> 4, i = rho & 15; return 8 * (i >> 2) + 4 * n + (i & 3); }

struct Unit { int pm, pn; };
struct Gemm { const bf16_t* A; const bf16_t* Bt; int M, N, K; };

struct StaticOrder {
    int nM, nN, nwg, G, c;
    __host__ __device__ void init(int M, int N, int G_, int c_) { nM = M / BM; nN = N / BM; nwg = nM * nN; G = G_; c = c_; }
    __host__ __device__ bool next(int i, Unit& u) const {
        const long L = (long)i * G + c; if (L >= nwg) return false;
        int wgid = (int)L; { const int q = nwg / NXCD, r = nwg % NXCD, xcd = wgid % NXCD, off = wgid / NXCD; wgid = (xcd < r ? xcd * (q + 1) : r * (q + 1) + (xcd - r) * q) + off; }
        const int nig = WGM * nN, gid = wgid / nig, fm = gid * WGM, gsz = (nM - fm) < WGM ? (nM - fm) : WGM;
        u.pm = fm + ((wgid % nig) % gsz); u.pn = (wgid % nig) / gsz; return true;
    }
    __device__ __forceinline__ void a_ready(const Unit&) const {}
    __device__ __forceinline__ void done(const Unit&) const {}
};

__device__ __forceinline__ unsigned cvt_pk_bf16(float lo, float hi) { unsigned r; asm volatile("v_cvt_pk_bf16_f32 %0, %1, %2" : "=v"(r) : "v"(lo), "v"(hi)); return r; }
typedef float f32x2 __attribute__((ext_vector_type(2)));
__device__ __forceinline__ f32x2 gelu_pk(f32x2 v) {
    const f32x2 av = __builtin_elementwise_abs(v), d = av * 0.2316418882f + 1.0f;
    f32x2 t; t.x = __builtin_amdgcn_rcpf(d.x); t.y = __builtin_amdgcn_rcpf(d.y);
    f32x2 q = t * 0.5307027145f + (-0.7265760135f); q = q * t + 0.7107068705f; q = q * t + (-0.142248368f); q = q * t + 0.127414796f; q = q * t;
    const f32x2 s = (v * v) * (-0.72134752044f);
    f32x2 e; e.x = __builtin_amdgcn_exp2f(s.x); e.y = __builtin_amdgcn_exp2f(s.y);
    const f32x2 m = v * (q * e), r = v - m;
    f32x2 o; o.x = v.x < 0.f ? m.x : r.x; o.y = v.y < 0.f ? m.y : r.y; return o;
}

template <int ACT  > struct EpiBf16 {
    static constexpr bool PERM = true, AFTER_DRAIN = false; static_assert(ACT == 0 || ACT == 1, "EpiBf16: ACT is 0 (none) or 1 (gelu_pk)");
    bf16_t* O; int ldc; const float* bias; int split_cols; size_t split_stride; float scale0;
    __device__ __forceinline__ void operator()(const f32x4 (&acc)[2][2][4][2], const Unit& u, int wr, int wc, int fr, int fq) const {
        const int row0 = u.pm * BM + wr * 64 + fr; int colt = u.pn * BM; bf16_t* base = O;
        float sc = 1.f; if (split_cols) { const int t = colt / split_cols; base += (size_t)t * split_stride; colt -= t * split_cols; if (t == 0) sc = scale0; }
        const int col0 = colt + wc * 32 + 8 * fq, bcol0 = u.pn * BM + wc * 32 + 8 * fq;
        f32x4 bv[2][2];
#pragma unroll
        for (int bj = 0; bj < 2; ++bj)
#pragma unroll
            for (int n = 0; n < 2; ++n) bv[bj][n] = bias ? *(const f32x4*)(bias + bcol0 + bj * HALF + 4 * n) : (f32x4){0.f, 0.f, 0.f, 0.f};
#pragma unroll
        for (int ai = 0; ai < 2; ++ai)
#pragma unroll
            for (int m = 0; m < 4; ++m) { bf16_t* rowp = base + (size_t)(row0 + ai * HALF + m * 16) * ldc + col0;
#pragma unroll
                for (int bj = 0; bj < 2; ++bj) { f32x4 v0 = acc[ai][bj][m][0] + bv[bj][0], v1 = acc[ai][bj][m][1] + bv[bj][1];
                    if (ACT == 1) { f32x2 a = gelu_pk((f32x2){v0[0], v0[1]}), b = gelu_pk((f32x2){v0[2], v0[3]}), c = gelu_pk((f32x2){v1[0], v1[1]}), d = gelu_pk((f32x2){v1[2], v1[3]});
                        v0 = (f32x4){a.x, a.y, b.x, b.y}; v1 = (f32x4){c.x, c.y, d.x, d.y}; }
                    v0 = v0 * sc; v1 = v1 * sc; u32x4 w; w.x = cvt_pk_bf16(v0[0], v0[1]); w.y = cvt_pk_bf16(v0[2], v0[3]); w.z = cvt_pk_bf16(v1[0], v1[1]); w.w = cvt_pk_bf16(v1[2], v1[3]);
                    *(u32x4*)(rowp + bj * HALF) = w; } }
    }
};
struct EpiF32 {
    static constexpr bool PERM = false, AFTER_DRAIN = false;
    float* C; int ldc;
    __device__ __forceinline__ void operator()(const f32x4 (&acc)[2][2][4][2], const Unit& u, int wr, int wc, int fr, int fq) const {
        const int row0 = u.pm * BM + wr * 64 + fr, col0 = u.pn * BM + wc * 32 + 4 * fq;
#pragma unroll
        for (int ai = 0; ai < 2; ++ai)
#pragma unroll
            for (int m = 0; m < 4; ++m) { float* rowp = C + (size_t)(row0 + ai * HALF + m * 16) * ldc + col0;
#pragma unroll
                for (int bj = 0; bj < 2; ++bj)
#pragma unroll
                    for (int n = 0; n < 2; ++n) *(f32x4*)(rowp + bj * HALF + n * 16) = acc[ai][bj][m][n]; }
    }
};
struct EpiResid {
    static constexpr bool PERM = false, AFTER_DRAIN = false;
    const float* res; float* out; int ldc; float alpha;
    __device__ __forceinline__ void operator()(const f32x4 (&acc)[2][2][4][2], const Unit& u, int wr, int wc, int fr, int fq) const {
        const int row0 = u.pm * BM + wr * 64 + fr, col0 = u.pn * BM + wc * 32 + 4 * fq;
        f32x4 cur[2][2], nxt[2][2];
        { const size_t off = (size_t)row0 * ldc + col0;
#pragma unroll
          for (int bj = 0; bj < 2; ++bj)
#pragma unroll
              for (int n = 0; n < 2; ++n) cur[bj][n] = *(const f32x4*)(res + off + bj * HALF + n * 16); }
#pragma unroll
        for (int gidx = 0; gidx < 8; ++gidx) { const int ai = gidx >> 2, m = gidx & 3;
            const size_t off = (size_t)(row0 + ai * HALF + m * 16) * ldc + col0;
            if (gidx < 7) { const int ai2 = (gidx + 1) >> 2, m2 = (gidx + 1) & 3; const size_t off2 = (size_t)(row0 + ai2 * HALF + m2 * 16) * ldc + col0;
#pragma unroll
                for (int bj = 0; bj < 2; ++bj)
#pragma unroll
                    for (int n = 0; n < 2; ++n) nxt[bj][n] = *(const f32x4*)(res + off2 + bj * HALF + n * 16); }
#pragma unroll
            for (int bj = 0; bj < 2; ++bj)
#pragma unroll
                for (int n = 0; n < 2; ++n) *(f32x4*)(out + off + bj * HALF + n * 16) = cur[bj][n] + acc[ai][bj][m][n] * alpha;
#pragma unroll
            for (int bj = 0; bj < 2; ++bj)
#pragma unroll
                for (int n = 0; n < 2; ++n) cur[bj][n] = nxt[bj][n];
        }
    }
};
struct EpiSwiGLU {
    static constexpr bool PERM = true, AFTER_DRAIN = false;
    bf16_t* O; int ldc;
    __device__ __forceinline__ static float silu_mul(float g, float u) { const float e = __builtin_amdgcn_exp2f(g * -1.4426950408889634f); return g * u * __builtin_amdgcn_rcpf(1.0f + e); }
    __device__ __forceinline__ void operator()(const f32x4 (&acc)[2][2][4][2], const Unit& u, int wr, int wc, int fr, int fq) const {
        const int row0 = u.pm * BM + wr * 64 + fr, col0 = u.pn * HALF + wc * 32 + 8 * fq;
#pragma unroll
        for (int ai = 0; ai < 2; ++ai)
#pragma unroll
            for (int m = 0; m < 4; ++m) { bf16_t* rowp = O + (size_t)(row0 + ai * HALF + m * 16) * ldc + col0;
                const f32x4 g0 = acc[ai][0][m][0], g1 = acc[ai][0][m][1], u0 = acc[ai][1][m][0], u1 = acc[ai][1][m][1];
                u32x4 w; w.x = cvt_pk_bf16(silu_mul(g0[0], u0[0]), silu_mul(g0[1], u0[1])); w.y = cvt_pk_bf16(silu_mul(g0[2], u0[2]), silu_mul(g0[3], u0[3]));
                w.z = cvt_pk_bf16(silu_mul(g1[0], u1[0]), silu_mul(g1[1], u1[1])); w.w = cvt_pk_bf16(silu_mul(g1[2], u1[2]), silu_mul(g1[3], u1[3]));
                *(u32x4*)rowp = w; }
    }
};
template <class Epi, class Sched, bool ALIGN_EPI = false, bool SP2 = false>
__device__ __forceinline__ void gemm_phase(PG8_LAS unsigned char* lds, const Gemm g, const Sched& S, const Epi& E) {
    const int tid = threadIdx.x, wid = __builtin_amdgcn_readfirstlane(tid >> 6), lane = tid & 63, wr = wid >> 2, wc = wid & 3, fr = lane & 15, fq = lane >> 4;
    const int K = g.K, nt = K / BK;
    unsigned voffA[2], voffB[2];
#pragma unroll
    for (int i = 0; i < 2; ++i) { int R, C; stage_rc(tid * 16 + i * 8192, R, C); const int Rb = Epi::PERM ? ((R & ~31) + perm32(R & 31)) : R;
        voffA[i] = (unsigned)(R * K + C) * 2u; voffB[i] = (unsigned)(Rb * K + C) * 2u; }
    const size_t kstep = (size_t)(BK * 2);
    const size_t hstep = (size_t)HALF * K * 2;
    const size_t tstep = 2 * hstep;
    const unsigned ldsw = (unsigned)wid * 1024u;
    const int aoff = lds_byte(wr * 64 + fr, fq * 8), boff = lds_byte(wc * 32 + fr, fq * 8);
#define PG8_SA(b, h) (((b) * 2 + (h)) * HTB)
#define PG8_SB(b, h) ((4 + (b) * 2 + (h)) * HTB)
#define PG8_STAGE(bufoff, gbase, voff) do { _Pragma("unroll") for (int _i = 0; _i < 2; ++_i) \
        __builtin_amdgcn_global_load_lds((const unsigned*)((const char*)(gbase) + (voff)[_i]), (PG8_LAS unsigned*)(lds + (bufoff) + ldsw + _i * 8192), 16, 0, 0); } while (0)
#define PG8_LDA(dst, b, h) do { _Pragma("unroll") for (int m = 0; m < 4; ++m) _Pragma("unroll") for (int k = 0; k < 2; ++k) dst[m][k] = *(const PG8_LAS bf16x8*)(lds + PG8_SA(b, h) + aoff + m * 2048 + k * 1024); } while (0)
#define PG8_LDB(dst, b, h) do { _Pragma("unroll") for (int n = 0; n < 2; ++n) _Pragma("unroll") for (int k = 0; k < 2; ++k) dst[n][k] = *(const PG8_LAS bf16x8*)(lds + PG8_SB(b, h) + boff + n * 2048 + k * 1024); } while (0)
#define PG8_MMA(ai, bj, At, Bt) do { __builtin_amdgcn_s_setprio(1); _Pragma("unroll") for (int m = 0; m < 4; ++m) _Pragma("unroll") for (int n = 0; n < 2; ++n) _Pragma("unroll") for (int k = 0; k < 2; ++k) \
        acc[ai][bj][m][n] = __builtin_amdgcn_mfma_f32_16x16x32_bf16(Bt[n][k], At[m][k], acc[ai][bj][m][n], 0, 0, 0); __builtin_amdgcn_s_setprio(0); } while (0)
#define PG8_WAIT_V(n) asm volatile("s_waitcnt vmcnt(" #n ")" ::: "memory")
#define PG8_WAIT_L(n) asm volatile("s_waitcnt lgkmcnt(" #n ")" ::: "memory")
#define PG8_BAR __builtin_amdgcn_s_barrier()
#define PG8_SCHED __builtin_amdgcn_sched_barrier(0)
    Unit cur, nxt; int ui = 0;
    if (!S.next(0, cur)) return;
    f32x4 acc[2][2][4][2];
#pragma unroll
    for (int a = 0; a < 2; ++a)
#pragma unroll
        for (int b = 0; b < 2; ++b)
#pragma unroll
            for (int m = 0; m < 4; ++m)
#pragma unroll
                for (int n = 0; n < 2; ++n) acc[a][b][m][n] = (f32x4){0.f, 0.f, 0.f, 0.f};
    bf16x8 At[4][2], B0[2][2], B1[2][2];
    const char* cA = (const char*)g.A + (size_t)cur.pm * tstep; const char* cB = (const char*)g.Bt + (size_t)cur.pn * tstep;
    S.a_ready(cur);
    if constexpr (SP2) {
        PG8_STAGE(PG8_SB(0, 0), cB, voffB); PG8_STAGE(PG8_SB(0, 1), cB + hstep, voffB); PG8_STAGE(PG8_SA(0, 0), cA, voffA); PG8_STAGE(PG8_SA(0, 1), cA + hstep, voffA);
        if (wr == 1) PG8_BAR;
        PG8_WAIT_V(2); PG8_BAR;
        PG8_STAGE(PG8_SB(1, 0), cB + kstep, voffB); PG8_STAGE(PG8_SA(1, 0), cA + kstep, voffA); PG8_STAGE(PG8_SB(1, 1), cB + hstep + kstep, voffB);
        PG8_WAIT_V(6); PG8_BAR;
    } else {
        PG8_STAGE(PG8_SB(0, 0), cB, voffB); PG8_STAGE(PG8_SA(0, 0), cA, voffA); PG8_STAGE(PG8_SB(0, 1), cB + hstep, voffB); PG8_STAGE(PG8_SA(0, 1), cA + hstep, voffA);
        if (wr == 1) PG8_BAR;
        PG8_WAIT_V(4); PG8_BAR;
        PG8_STAGE(PG8_SB(1, 0), cB + kstep, voffB); PG8_STAGE(PG8_SA(1, 0), cA + kstep, voffA); PG8_STAGE(PG8_SB(1, 1), cB + hstep + kstep, voffB);
        PG8_WAIT_V(6); PG8_BAR;
    }
    for (;;) {
        const bool has_next = S.next(ui + 1, nxt);
        const char* nA = has_next ? (const char*)g.A + (size_t)nxt.pm * tstep : cA; const char* nB = has_next ? (const char*)g.Bt + (size_t)nxt.pn * tstep : cB;
        for (int t = 0; t < nt; t += 2) {
            const bool last = (t == nt - 2);
            const char* a1 = cA + (size_t)(t + 1) * kstep;
            const char* a2 = last ? nA : cA + (size_t)(t + 2) * kstep; const char* b2 = last ? nB : cB + (size_t)(t + 2) * kstep;
            const char* a3 = a2 + kstep; const char* b3 = b2 + kstep;
            if (last && has_next) S.a_ready(nxt);
            if constexpr (SP2) {
            PG8_LDB(B0, 0, 0); PG8_LDB(B1, 0, 1); PG8_SCHED; PG8_LDA(At, 0, 0); PG8_STAGE(PG8_SA(1, 1), a1 + hstep, voffA);
            PG8_WAIT_V(8); PG8_WAIT_L(0); PG8_BAR; PG8_MMA(0, 0, At, B0); PG8_MMA(0, 1, At, B1); PG8_BAR; PG8_SCHED;
            PG8_LDA(At, 0, 1); PG8_STAGE(PG8_SB(0, 0), b2, voffB); PG8_STAGE(PG8_SB(0, 1), b2 + hstep, voffB); PG8_STAGE(PG8_SA(0, 0), a2, voffA);
            PG8_WAIT_V(8); PG8_WAIT_L(0); PG8_BAR; PG8_MMA(1, 0, At, B0); PG8_MMA(1, 1, At, B1); PG8_BAR; PG8_SCHED;
            PG8_LDB(B0, 1, 0); PG8_LDB(B1, 1, 1); PG8_SCHED; PG8_LDA(At, 1, 0); PG8_STAGE(PG8_SA(0, 1), a2 + hstep, voffA);
            PG8_WAIT_V(8); PG8_WAIT_L(0); PG8_BAR; PG8_MMA(0, 0, At, B0); PG8_MMA(0, 1, At, B1); PG8_BAR; PG8_SCHED;
            PG8_LDA(At, 1, 1); PG8_STAGE(PG8_SB(1, 0), b3, voffB); PG8_STAGE(PG8_SB(1, 1), b3 + hstep, voffB); PG8_STAGE(PG8_SA(1, 0), a3, voffA);
            PG8_WAIT_V(8); PG8_WAIT_L(0); PG8_BAR; PG8_MMA(1, 0, At, B0); PG8_MMA(1, 1, At, B1); PG8_BAR; PG8_SCHED;
            } else {
            PG8_LDB(B0, 0, 0); PG8_SCHED; PG8_LDA(At, 0, 0); PG8_STAGE(PG8_SA(1, 1), a1 + hstep, voffA);
            PG8_WAIT_L(8); PG8_BAR; PG8_WAIT_L(0); PG8_MMA(0, 0, At, B0); PG8_BAR; PG8_SCHED;
            PG8_LDB(B1, 0, 1); PG8_STAGE(PG8_SB(0, 0), b2, voffB);
            PG8_BAR; PG8_WAIT_L(0); PG8_MMA(0, 1, At, B1); PG8_BAR;
            PG8_LDA(At, 0, 1); PG8_STAGE(PG8_SA(0, 0), a2, voffA);
            PG8_BAR; PG8_WAIT_L(0); PG8_MMA(1, 0, At, B0); PG8_BAR; PG8_SCHED;
            PG8_STAGE(PG8_SB(0, 1), b2 + hstep, voffB);
            PG8_WAIT_V(6); PG8_BAR; PG8_MMA(1, 1, At, B1); PG8_BAR;
            PG8_LDB(B0, 1, 0); PG8_SCHED; PG8_LDA(At, 1, 0); PG8_STAGE(PG8_SA(0, 1), a2 + hstep, voffA);
            PG8_WAIT_L(8); PG8_BAR; PG8_WAIT_L(0); PG8_MMA(0, 0, At, B0); PG8_BAR; PG8_SCHED;
            PG8_LDB(B1, 1, 1); PG8_STAGE(PG8_SB(1, 0), b3, voffB);
            PG8_BAR; PG8_WAIT_L(0); PG8_MMA(0, 1, At, B1); PG8_BAR;
            PG8_LDA(At, 1, 1); PG8_STAGE(PG8_SA(1, 0), a3, voffA);
            PG8_BAR; PG8_WAIT_L(0); PG8_MMA(1, 0, At, B0); PG8_BAR; PG8_SCHED;
            PG8_STAGE(PG8_SB(1, 1), b3 + hstep, voffB);
            PG8_WAIT_V(6); PG8_BAR; PG8_MMA(1, 1, At, B1); PG8_BAR;
            }
        }
        if constexpr (ALIGN_EPI) { if (wr == 0) PG8_BAR; }
        if constexpr (!Epi::AFTER_DRAIN) { E(acc, cur, wr, wc, fr, fq); S.done(cur); }
        if (!has_next) break;
#pragma unroll
        for (int a = 0; a < 2; ++a)
#pragma unroll
            for (int b = 0; b < 2; ++b)
#pragma unroll
                for (int m = 0; m < 4; ++m)
#pragma unroll
                    for (int n = 0; n < 2; ++n) acc[a][b][m][n] = (f32x4){0.f, 0.f, 0.f, 0.f};
        cur = nxt; cA = nA; cB = nB; ++ui;
        if constexpr (ALIGN_EPI) { if (wr == 1) PG8_BAR; }
    }
    PG8_WAIT_V(0);
    if constexpr (!ALIGN_EPI) { if (wr == 0) PG8_BAR; }
    PG8_BAR;
    if constexpr (Epi::AFTER_DRAIN) { E.fused(acc, cur, wr, wc, fr, fq, lds, wid, lane); S.done(cur); }
#undef PG8_SA
#undef PG8_SB
#undef PG8_STAGE
#undef PG8_LDA
#undef PG8_LDB
#undef PG8_MMA
#undef PG8_WAIT_V
#undef PG8_WAIT_L
#undef PG8_BAR
#undef PG8_SCHED
}
}
namespace att {
#define ATT_LAS __attribute__((address_space(3)))
typedef unsigned short bf16_t;
using bf16x8 = __attribute__((ext_vector_type(8))) short;
using s16x4  = __attribute__((ext_vector_type(4))) short;
using f32x16 = __attribute__((ext_vector_type(16))) float;
using f32x4  = __attribute__((ext_vector_type(4))) float;
using u32x4  = __attribute__((ext_vector_type(4))) unsigned;
#define ATT_SBAR() __builtin_amdgcn_sched_barrier(0)
constexpr float THR2 = 8.0f;
constexpr float LOG2E = 1.4426950408889634f;
__device__ __forceinline__ int crow(int r, int hi) { return (r & 3) + 8 * (r >> 2) + 4 * hi; }
__device__ __forceinline__ unsigned cvtpk(float lo, float hi) { unsigned r; asm volatile("v_cvt_pk_bf16_f32 %0, %1, %2" : "=v"(r) : "v"(lo), "v"(hi)); return r; }
__device__ __forceinline__ float bf2f(short x) { return __uint_as_float(((unsigned)(unsigned short)x) << 16); }
__device__ __forceinline__ void glds16(const void* gsrc, unsigned lds_dst) { unsigned keep;
  asm volatile("s_mov_b32 %0, m0\n\ts_mov_b32 m0, %2\n\ts_nop 0\n\tglobal_load_lds_dwordx4 %1, off\n\ts_mov_b32 m0, %0" : "=&s"(keep) : "v"(gsrc), "s"(lds_dst) : "memory"); }
#define ATT_WAIT_BAR() asm volatile("s_waitcnt vmcnt(0) lgkmcnt(0)\n\ts_barrier" ::: "memory")

__device__ __forceinline__ void partialSM2(f32x16& p0, f32x16& p1, float& m_reg, float& alpha) {
  float pmax = p0[0];
#pragma unroll
  for (int r = 1; r < 16; ++r) pmax = fmaxf(pmax, p0[r]);
#pragma unroll
  for (int r = 0; r < 16; ++r) pmax = fmaxf(pmax, p1[r]);
  { auto rr = __builtin_amdgcn_permlane32_swap(__float_as_uint(pmax), __float_as_uint(pmax), false, false);
    pmax = fmaxf(__uint_as_float(rr[0]), __uint_as_float(rr[1])); }
  if (__builtin_expect(__all(pmax - m_reg <= THR2), 1)) { alpha = 1.f; }
  else { const float mn = fmaxf(m_reg, pmax); alpha = __builtin_amdgcn_exp2f(m_reg - mn); m_reg = mn; }
#pragma unroll
  for (int r = 0; r < 16; ++r) { p0[r] -= m_reg; p1[r] -= m_reg; }
#pragma unroll
  for (int r = 0; r < 16; ++r) p0[r] = __builtin_amdgcn_exp2f(p0[r]);
}
__device__ __forceinline__ void finishSM(f32x16& p0, f32x16& p1, float alpha, float& l_reg, bf16x8& pa0, bf16x8& pa1, bf16x8& pa2, bf16x8& pa3) {
#pragma unroll
  for (int r = 0; r < 16; ++r) p1[r] = __builtin_amdgcn_exp2f(p1[r]);
  float ps = 0;
#pragma unroll
  for (int r = 0; r < 16; ++r) ps += p0[r];
#pragma unroll
  for (int r = 0; r < 16; ++r) ps += p1[r];
  { auto rr = __builtin_amdgcn_permlane32_swap(__float_as_uint(ps), __float_as_uint(ps), false, false);
    ps = __uint_as_float(rr[0]) + __uint_as_float(rr[1]); }
  l_reg = l_reg * alpha + ps;
#define ATT_PK4(P, BASE, OUT) do { unsigned a0 = cvtpk(P[BASE + 0], P[BASE + 1]), a1 = cvtpk(P[BASE + 2], P[BASE + 3]);   \
    unsigned b0 = cvtpk(P[BASE + 4], P[BASE + 5]), b1 = cvtpk(P[BASE + 6], P[BASE + 7]);                              \
    auto r0 = __builtin_amdgcn_permlane32_swap(a0, b0, false, false); auto r1 = __builtin_amdgcn_permlane32_swap(a1, b1, false, false); \
    u32x4 w = {r0[0], r1[0], r0[1], r1[1]}; OUT = *reinterpret_cast<bf16x8*>(&w); } while (0)
  ATT_PK4(p0, 0, pa0); ATT_PK4(p0, 8, pa1); ATT_PK4(p1, 0, pa2); ATT_PK4(p1, 8, pa3);
#undef ATT_PK4
}
__device__ __forceinline__ int v_rd_base(int lane) { return ((lane & 3) << 3) | (((lane >> 2) & 3) << 6) | (((lane >> 4) & 1) << 5) | (((lane >> 5) & 1) << 8); }
template <int OFF> __device__ __forceinline__ s16x4 tr_read(int vb) {
  s16x4 r; asm volatile("ds_read_b64_tr_b16 %0, %1 offset:%2" : "=&v"(r) : "v"(vb), "i"(OFF) : "memory"); return r;
}
template <int NCB, int D0> __device__ __forceinline__ void pv_one(f32x16& od, int vb, bf16x8 pa0, bf16x8 pa1, bf16x8 pa2, bf16x8 pa3) {
  constexpr int KS = 1024 * NCB, HF = 512 * NCB;
  const s16x4 l0 = tr_read<D0 * 512 + 0 * KS>(vb), h0 = tr_read<D0 * 512 + 0 * KS + HF>(vb), l1 = tr_read<D0 * 512 + 1 * KS>(vb), h1 = tr_read<D0 * 512 + 1 * KS + HF>(vb);
  const s16x4 l2 = tr_read<D0 * 512 + 2 * KS>(vb), h2 = tr_read<D0 * 512 + 2 * KS + HF>(vb), l3 = tr_read<D0 * 512 + 3 * KS>(vb), h3 = tr_read<D0 * 512 + 3 * KS + HF>(vb);
  asm volatile("s_waitcnt lgkmcnt(0)" ::: "memory"); ATT_SBAR();
#define ATT_PK(L, H) (bf16x8){L[0], L[1], L[2], L[3], H[0], H[1], H[2], H[3]}
  od = __builtin_amdgcn_mfma_f32_32x32x16_bf16(pa0, ATT_PK(l0, h0), od, 0, 0, 0);
  od = __builtin_amdgcn_mfma_f32_32x32x16_bf16(pa1, ATT_PK(l1, h1), od, 0, 0, 0);
  od = __builtin_amdgcn_mfma_f32_32x32x16_bf16(pa2, ATT_PK(l2, h2), od, 0, 0, 0);
  od = __builtin_amdgcn_mfma_f32_32x32x16_bf16(pa3, ATT_PK(l3, h3), od, 0, 0, 0);
#undef ATT_PK
}
#define ATT_RESC(ND, a) do { if (__any((a) < 1.f)) { if (hi == 0) al_l[r32] = (a); asm volatile("s_waitcnt lgkmcnt(0)" ::: "memory"); \
    _Pragma("unroll") for (int d_ = 0; d_ < ND; ++d_) _Pragma("unroll") for (int r_ = 0; r_ < 16; ++r_) o[d_][r_] *= al_l[crow(r_, hi)]; } } while (0)

namespace mla {
constexpr int S = 8192, LDQ = 3072, LDK = 3072, LDV = 4096, LDO = 2048, NT = S / 64;
constexpr int KP = 400, KT = 64 * KP, VT = 16384, K_OFF0 = 0, K_OFF1 = KT, V_OFF0 = 2 * KT, V_OFF1 = 2 * KT + VT, LDS_END = 2 * KT + 2 * VT;
constexpr int OST_PITCH = 136;
static_assert(8 * 32 * OST_PITCH * 2 <= LDS_END, "O staging fits in the K/V region");
__device__ __forceinline__ void qkt(f32x16& p0, f32x16& p1, const ATT_LAS unsigned char* Ks, const bf16x8* qr, int r32, int hi) {
  p0 = f32x16{}; p1 = f32x16{};
  const ATT_LAS unsigned char* kb = Ks + r32 * KP + hi * 16;
#pragma unroll
  for (int d0 = 0; d0 < 12; ++d0) {
    const bf16x8 b0 = *reinterpret_cast<const ATT_LAS bf16x8*>(kb + d0 * 32);
    const bf16x8 b1 = *reinterpret_cast<const ATT_LAS bf16x8*>(kb + 32 * KP + d0 * 32);
    p0 = __builtin_amdgcn_mfma_f32_32x32x16_bf16(b0, qr[d0], p0, 0, 0, 0);
    p1 = __builtin_amdgcn_mfma_f32_32x32x16_bf16(b1, qr[d0], p1, 0, 0, 0); }
}
__device__ __forceinline__ void pv4(f32x16* o, int vb, bf16x8 pa0, bf16x8 pa1, bf16x8 pa2, bf16x8 pa3) {
  pv_one<4, 0>(o[0], vb, pa0, pa1, pa2, pa3); pv_one<4, 1>(o[1], vb, pa0, pa1, pa2, pa3); pv_one<4, 2>(o[2], vb, pa0, pa1, pa2, pa3); pv_one<4, 3>(o[3], vb, pa0, pa1, pa2, pa3);
}
__device__ __forceinline__ void unit(ATT_LAS unsigned char* lds, ATT_LAS float* wscr, const bf16_t* __restrict__ Qn, const bf16_t* __restrict__ Kn, const bf16_t* __restrict__ KV, bf16_t* __restrict__ O, int h, int qb) {
  const int tid = threadIdx.x, lane = tid & 63, r32 = lane & 31, hi = lane >> 5; const int wid = __builtin_amdgcn_readfirstlane(tid >> 6);
  const unsigned lds0 = (unsigned)(uintptr_t)lds;
  ATT_LAS float* al_l = wscr + wid * 64; ATT_LAS float* li_l = al_l + 32;
  const bf16_t* Kh = Kn + h * 192; const bf16_t* Vh = KV + h * 256 + 128;
  int koff[4], voff[2];
#pragma unroll
  for (int i = 0; i < 4; ++i) { const int p = (wid + 8 * i) * 64 + lane, row = p / 25, c = p % 25; koff[i] = row * LDK + (c < 24 ? c : 23) * 8; }
#pragma unroll
  for (int i = 0; i < 2; ++i) { const int B = (wid + 8 * i) * 1024 + lane * 16, st = B >> 9, wi = B & 511, kk = (st >> 2) * 8 + (wi >> 6), c = (st & 3) * 32 + ((wi & 63) >> 1);
    const int k = (kk & ~0xC) | ((kk & 4) << 1) | ((kk & 8) >> 1); voff[i] = k * LDV + c; }
#define MLA_DMA_K(t, buf) do { const bf16_t* kt_ = Kh + (size_t)(t) * 64 * LDK; \
    glds16(kt_ + koff[0], lds0 + (buf) + (unsigned)wid * 1024u); glds16(kt_ + koff[1], lds0 + (buf) + (unsigned)(wid + 8) * 1024u); glds16(kt_ + koff[2], lds0 + (buf) + (unsigned)(wid + 16) * 1024u); \
    if (wid == 0) glds16(kt_ + koff[3], lds0 + (buf) + 24u * 1024u); } while (0)
#define MLA_DMA_V(t, buf) do { const bf16_t* vt_ = Vh + (size_t)(t) * 64 * LDV; \
    glds16(vt_ + voff[0], lds0 + (buf) + (unsigned)wid * 1024u); glds16(vt_ + voff[1], lds0 + (buf) + (unsigned)(wid + 8) * 1024u); } while (0)
  MLA_DMA_K(0, K_OFF0); MLA_DMA_V(0, V_OFF0);
  bf16x8 qr[12];
  { const bf16_t* Qw = Qn + (size_t)(qb * 256 + wid * 32 + r32) * LDQ + h * 192 + hi * 8;
#pragma unroll
    for (int d0 = 0; d0 < 12; ++d0) qr[d0] = *reinterpret_cast<const bf16x8*>(Qw + d0 * 16); }
  float m_reg = -1e30f, l_reg = 0.f; f32x16 o[4] = {};
  f32x16 pA0, pA1, pB0, pB1; float alA, alB; bf16x8 pa0, pa1, pa2, pa3;
  const int vb0 = (int)(lds0 + V_OFF0) + v_rd_base(lane), vb1 = (int)(lds0 + V_OFF1) + v_rd_base(lane);
  const ATT_LAS unsigned char* K0p = lds + K_OFF0; const ATT_LAS unsigned char* K1p = lds + K_OFF1;
  ATT_WAIT_BAR();
  MLA_DMA_K(1, K_OFF1);
  qkt(pA0, pA1, K0p, qr, r32, hi); partialSM2(pA0, pA1, m_reg, alA);
  ATT_WAIT_BAR();
#pragma unroll 1
  for (int j = 1; j + 1 < NT; j += 2) {
    MLA_DMA_K(j + 1, K_OFF0); MLA_DMA_V(j, V_OFF1);
    ATT_SBAR(); qkt(pB0, pB1, K1p, qr, r32, hi);
    finishSM(pA0, pA1, alA, l_reg, pa0, pa1, pa2, pa3); ATT_SBAR();
    pv4(o, vb0, pa0, pa1, pa2, pa3); partialSM2(pB0, pB1, m_reg, alB);
    ATT_RESC(4, alB);
    ATT_WAIT_BAR();
    if (j + 2 < NT) MLA_DMA_K(j + 2, K_OFF1);
    MLA_DMA_V(j + 1, V_OFF0);
    ATT_SBAR(); qkt(pA0, pA1, K0p, qr, r32, hi);
    finishSM(pB0, pB1, alB, l_reg, pa0, pa1, pa2, pa3); ATT_SBAR();
    pv4(o, vb1, pa0, pa1, pa2, pa3); partialSM2(pA0, pA1, m_reg, alA);
    ATT_RESC(4, alA);
    ATT_WAIT_BAR();
  }
  MLA_DMA_V(NT - 1, V_OFF1);
  ATT_SBAR(); qkt(pB0, pB1, K1p, qr, r32, hi);
  finishSM(pA0, pA1, alA, l_reg, pa0, pa1, pa2, pa3); ATT_SBAR();
  pv4(o, vb0, pa0, pa1, pa2, pa3); partialSM2(pB0, pB1, m_reg, alB);
  ATT_RESC(4, alB);
  ATT_WAIT_BAR();
  finishSM(pB0, pB1, alB, l_reg, pa0, pa1, pa2, pa3); ATT_SBAR();
  pv4(o, vb1, pa0, pa1, pa2, pa3);
  if (hi == 0) li_l[r32] = l_reg;
  ATT_WAIT_BAR();
  float rli[16];
#pragma unroll
  for (int r = 0; r < 16; ++r) rli[r] = __builtin_amdgcn_rcpf(li_l[crow(r, hi)]);
  ATT_LAS bf16_t* stg = (ATT_LAS bf16_t*)lds + wid * (32 * OST_PITCH);
#pragma unroll
  for (int r = 0; r < 16; ++r) { const int orow = crow(r, hi);
#pragma unroll
    for (int d0 = 0; d0 < 4; ++d0) { const unsigned w = cvtpk(o[d0][r] * rli[r], 0.f); stg[orow * OST_PITCH + d0 * 32 + r32] = (bf16_t)(w & 0xffffu); } }
  asm volatile("s_waitcnt lgkmcnt(0)" ::: "memory");
  bf16_t* Ow = O + (size_t)(qb * 256 + wid * 32) * LDO + h * 128;
#pragma unroll
  for (int i = 0; i < 8; ++i) { const int row = i * 4 + (lane >> 4), ch = lane & 15; const u32x4 v = *(const ATT_LAS u32x4*)(stg + row * OST_PITCH + ch * 8); *(u32x4*)(Ow + (size_t)row * LDO + ch * 8) = v; }
  ATT_WAIT_BAR();
#undef MLA_DMA_K
#undef MLA_DMA_V
}
}

namespace swa {
constexpr int S = 8192, LDQKV = 3072, LDO = 2048, NTILE = S / 64, KCOL = 2048, VCOL = 2560;
constexpr int K_OFF = 0, V_OFF = 65536, SLOT = 8192;
__device__ __forceinline__ void super_unit(ATT_LAS unsigned char* lds, ATT_LAS float* posk, ATT_LAS float* wscr, const bf16_t* __restrict__ QKV, const int* __restrict__ positions,
                                           const float* __restrict__ qg, const float* __restrict__ kg, const float* __restrict__ sink, bf16_t* __restrict__ O, int kvh, int jb) {
  const int tid = threadIdx.x, lane = tid & 63, r32 = lane & 31, hi = lane >> 5; const int wid = __builtin_amdgcn_readfirstlane(tid >> 6);
  const unsigned lds0 = (unsigned)(uintptr_t)lds;
  ATT_LAS float* al_l = wscr + wid * 64; ATT_LAS float* li_l = al_l + 32;
  const int T0 = 4 * jb - 2;
  { const int T = T0 + wid;
    if (T >= 0 && T < NTILE) {
      const bf16_t* kbase = QKV + (size_t)T * 64 * LDQKV + KCOL + kvh * 64; const bf16_t* vbase = QKV + (size_t)T * 64 * LDQKV + VCOL + kvh * 64;
#pragma unroll
      for (int pc = 0; pc < 8; ++pc) {
        const int row = pc * 8 + (lane >> 3), c = (lane & 7) ^ (row & 7);
        glds16(kbase + (size_t)row * LDQKV + c * 8, lds0 + K_OFF + (unsigned)wid * SLOT + (unsigned)pc * 1024u);
        const int kk = pc * 8 + ((lane & 31) >> 2), vc = (lane >> 5) * 32 + (lane & 3) * 8, k = (kk & ~0xC) | ((kk & 4) << 1) | ((kk & 8) >> 1);
        glds16(vbase + (size_t)k * LDQKV + vc, lds0 + V_OFF + (unsigned)wid * SLOT + (unsigned)pc * 1024u);
      }
    }
    const int s = 64 * T0 + tid; posk[tid] = (s >= 0 && s < S) ? (float)positions[s] : 0.f;
  }
  ATT_WAIT_BAR();
  { const int T = T0 + wid;
    if (T >= 0 && T < NTILE) {
      ATT_LAS unsigned char* rowp = lds + K_OFF + wid * SLOT + lane * 128;
      bf16x8 v[8]; float ss = 0.f;
#pragma unroll
      for (int c = 0; c < 8; ++c) { v[c] = *reinterpret_cast<const ATT_LAS bf16x8*>(rowp + c * 16);
#pragma unroll
        for (int e = 0; e < 8; ++e) { const float f = bf2f(v[c][e]); ss += f * f; } }
      const float rs = __builtin_amdgcn_rsqf(ss * (1.0f / 64.0f) + 1e-6f);
#pragma unroll
      for (int c = 0; c < 8; ++c) { u32x4 w; w.x = cvtpk(bf2f(v[c][0]) * rs, bf2f(v[c][1]) * rs); w.y = cvtpk(bf2f(v[c][2]) * rs, bf2f(v[c][3]) * rs);
        w.z = cvtpk(bf2f(v[c][4]) * rs, bf2f(v[c][5]) * rs); w.w = cvtpk(bf2f(v[c][6]) * rs, bf2f(v[c][7]) * rs); *reinterpret_cast<ATT_LAS u32x4*>(rowp + c * 16) = w; }
    }
  }
  ATT_WAIT_BAR();
  const int g = wid >> 1, hq = 4 * kvh + g;
  const float slope2 = __builtin_amdgcn_exp2f(-0.25f * (float)(hq + 1)) * LOG2E, sink2 = sink[hq] * LOG2E;
  const int vrb = (int)(lds0 + V_OFF) + v_rd_base(lane);
#pragma unroll 1
  for (int sb = 0; sb < 4; ++sb) {
    const int tw = 256 * jb + 64 * sb + 32 * (wid & 1), t = tw + r32;
    bf16x8 qr[4];
    { const bf16_t* Qp = QKV + (size_t)t * LDQKV + hq * 64 + hi * 8; bf16x8 raw[4]; float ss = 0.f;
#pragma unroll
      for (int d0 = 0; d0 < 4; ++d0) { raw[d0] = *reinterpret_cast<const bf16x8*>(Qp + d0 * 16);
#pragma unroll
        for (int e = 0; e < 8; ++e) { const float f = bf2f(raw[d0][e]); ss += f * f; } }
      { auto rr = __builtin_amdgcn_permlane32_swap(__float_as_uint(ss), __float_as_uint(ss), false, false); ss = __uint_as_float(rr[0]) + __uint_as_float(rr[1]); }
      const float rs = __builtin_amdgcn_rsqf(ss * (1.0f / 64.0f) + 1e-6f) * (0.125f * LOG2E);
#pragma unroll
      for (int d0 = 0; d0 < 4; ++d0) { const int dd = d0 * 16 + hi * 8; const f32x4 ga = *(const f32x4*)(qg + dd), gb = *(const f32x4*)(qg + dd + 4), ka = *(const f32x4*)(kg + dd), kb = *(const f32x4*)(kg + dd + 4);
        u32x4 w; w.x = cvtpk(bf2f(raw[d0][0]) * rs * ga[0] * ka[0], bf2f(raw[d0][1]) * rs * ga[1] * ka[1]); w.y = cvtpk(bf2f(raw[d0][2]) * rs * ga[2] * ka[2], bf2f(raw[d0][3]) * rs * ga[3] * ka[3]);
        w.z = cvtpk(bf2f(raw[d0][4]) * rs * gb[0] * kb[0], bf2f(raw[d0][5]) * rs * gb[1] * kb[1]); w.w = cvtpk(bf2f(raw[d0][6]) * rs * gb[2] * kb[2], bf2f(raw[d0][7]) * rs * gb[3] * kb[3]);
        qr[d0] = *reinterpret_cast<bf16x8*>(&w); } }
    const float posq = (float)positions[t];
    float m_reg = sink2, l_reg = 1.0f; f32x16 o[2] = {};
#pragma unroll 1
    for (int lt = sb; lt < sb + 5; ++lt) {
      const int T = T0 + lt; if (T < 0 || T >= NTILE) continue;
      f32x16 p0 = {}, p1 = {};
      { const ATT_LAS unsigned char* kb = lds + K_OFF + lt * SLOT + r32 * 128; const int sw = (r32 & 7) << 4;
#pragma unroll
        for (int d0 = 0; d0 < 4; ++d0) { const int cb = (d0 * 32 + hi * 16) ^ sw;
          const bf16x8 b0 = *reinterpret_cast<const ATT_LAS bf16x8*>(kb + cb); const bf16x8 b1 = *reinterpret_cast<const ATT_LAS bf16x8*>(kb + 4096 + cb);
          p0 = __builtin_amdgcn_mfma_f32_32x32x16_bf16(b0, qr[d0], p0, 0, 0, 0); p1 = __builtin_amdgcn_mfma_f32_32x32x16_bf16(b1, qr[d0], p1, 0, 0, 0); } }
      { const int delta = 64 * T - t + 4 * hi; const ATT_LAS float* pk = posk + 64 * lt + 4 * hi;
#pragma unroll
        for (int q4 = 0; q4 < 4; ++q4) { const f32x4 k0 = *reinterpret_cast<const ATT_LAS f32x4*>(pk + 8 * q4), k1 = *reinterpret_cast<const ATT_LAS f32x4*>(pk + 32 + 8 * q4);
#pragma unroll
          for (int e = 0; e < 4; ++e) { const int r = 4 * q4 + e, rel0 = delta + 8 * q4 + e, rel1 = rel0 + 32;
            const float s0 = p0[r] - slope2 * fabsf(posq - k0[e]), s1 = p1[r] - slope2 * fabsf(posq - k1[e]);
            p0[r] = ((unsigned)(rel0 + 128) <= 256u) ? s0 : -1e30f; p1[r] = ((unsigned)(rel1 + 128) <= 256u) ? s1 : -1e30f; } } }
      float al; bf16x8 pa0, pa1, pa2, pa3;
      partialSM2(p0, p1, m_reg, al); ATT_RESC(2, al);
      finishSM(p0, p1, al, l_reg, pa0, pa1, pa2, pa3); ATT_SBAR();
      pv_one<2, 0>(o[0], vrb + lt * SLOT, pa0, pa1, pa2, pa3); pv_one<2, 1>(o[1], vrb + lt * SLOT, pa0, pa1, pa2, pa3);
    }
    if (hi == 0) li_l[r32] = l_reg; asm volatile("s_waitcnt lgkmcnt(0)" ::: "memory");
    bf16_t* Ow = O + (size_t)tw * LDO + hq * 64;
#pragma unroll
    for (int r = 0; r < 16; ++r) { const int orow = crow(r, hi); const float rl = __builtin_amdgcn_rcpf(li_l[orow]);
#pragma unroll
      for (int d0 = 0; d0 < 2; ++d0) { const unsigned w = cvtpk(o[d0][r] * rl, 0.f); Ow[(size_t)orow * LDO + d0 * 32 + r32] = (bf16_t)(w & 0xffffu); } }
    asm volatile("s_waitcnt lgkmcnt(0)" ::: "memory");
  }
  ATT_WAIT_BAR();
}
}
}
constexpr int NWAVES = 8;
constexpr int S_ = 8192, DM = 2048, DFF = 5632, DEPTH = 4;
constexpr int MLA_NA = 1088, MLA_NA_PAD = 1280, MLA_NQ = 3072, MLA_NKV = 4096, MLA_R = 512;
constexpr int SWA_NQKV = 3072;
constexpr float RMS_EPS = 1e-6f;
#ifndef TEST_PROG
#define TEST_PROG 6
#endif
#ifndef TEST_NO_MLA
#define TEST_NO_MLA 0
#endif
#ifndef MK_PER_PHASE
#define MK_PER_PHASE 0
#endif

constexpr size_t MiB = 1u << 20;
constexpr size_t WS_CTL = 0, CTL_ZERO_BYTES = 1 * MiB;
constexpr size_t WS_COS = 1 * MiB, WS_SIN = 2 * MiB;
constexpr size_t WS_WFFN = 4 * MiB, FFN_STRIDE = 66 * MiB, FFN_WD_OFF = 44 * MiB;
constexpr size_t WS_WMLA = WS_WFFN + 8 * FFN_STRIDE, MLA_STRIDE = 20 * MiB, MLA_WUQ_OFF = 5 * MiB, MLA_WUKV_OFF = 8 * MiB, MLA_WO_OFF = 12 * MiB;
constexpr size_t WS_WSWA = WS_WMLA + 2 * MLA_STRIDE, SWA_STRIDE = 20 * MiB, SWA_WO_OFF = 12 * MiB;
constexpr size_t WS_XN = WS_WSWA + 2 * SWA_STRIDE;
constexpr size_t WS_ACT = WS_XN + 32 * MiB;
constexpr size_t WS_H = WS_ACT + 88 * MiB;
constexpr size_t WS_CQN = WS_H + 40 * MiB, WS_CKVN = WS_CQN + 8 * MiB;
constexpr size_t WS_Q = WS_CKVN + 8 * MiB;
constexpr size_t WS_KV = WS_Q + 48 * MiB;
constexpr size_t WS_KN = WS_KV + 64 * MiB;
constexpr size_t WS_O = WS_KN + 48 * MiB;
constexpr size_t WS_END = WS_O + 32 * MiB;
constexpr int CW_BAR = 4096;

constexpr int RING_OFF = 0, RING_BYTES = 131072;
constexpr int LDSCTL_OFF = RING_BYTES, MISC_OFF = LDSCTL_OFF + 320;
constexpr int POSK_OFF = RING_BYTES + 1024;
constexpr int WSCR_OFF = RING_BYTES + 4096;
constexpr int LDS_BYTES = 147456;
static_assert(att::mla::LDS_END <= RING_BYTES && WSCR_OFF + 8 * 256 <= LDS_BYTES && MISC_OFF + 128 <= POSK_OFF, "LDS map");

#define GAS __attribute__((address_space(1)))
#define LAS __attribute__((address_space(3)))
typedef unsigned short bf16;
typedef unsigned v4u __attribute__((ext_vector_type(4)));
typedef float f32x4 __attribute__((ext_vector_type(4)));
typedef short bf16x8 __attribute__((ext_vector_type(8)));
typedef GAS unsigned gu32;
typedef GAS unsigned long long gu64;
#define RLX_AGENT __ATOMIC_RELAXED, __HIP_MEMORY_SCOPE_AGENT
#define LDS_WAIT() asm volatile("s_waitcnt lgkmcnt(0)" ::: "memory")
#define VM_WAIT() asm volatile("s_waitcnt vmcnt(0)" ::: "memory")
__device__ __forceinline__ unsigned long long rt() { return __builtin_amdgcn_s_memrealtime(); }
__device__ __forceinline__ unsigned f2bf(float f) { unsigned u = __builtin_bit_cast(unsigned, f); return (u + 0x7fffu + ((u >> 16) & 1u)) >> 16; }
__device__ __forceinline__ unsigned pk2(float lo, float hi) { return f2bf(lo) | (f2bf(hi) << 16); }

#define XB_TMO      128
#define XB_XCNT(j)  (256  + 64 * (j))
#define XB_XSUB(j)  (1280 + 64 * (j))
#define XB_XGEN(j)  (2304 + 64 * (j))
#define XB_TOP      3328
#define XB_TOPGEN   3392
#define XCD_BAR_WORDS 3456
#define XB_SPIN_CAP (1u << 18)

__device__ __forceinline__ unsigned xb_ld(unsigned* p)              { return __hip_atomic_load(p, __ATOMIC_RELAXED, __HIP_MEMORY_SCOPE_AGENT); }
__device__ __forceinline__ unsigned xb_add(unsigned* p, unsigned v) { return __hip_atomic_fetch_add(p, v, __ATOMIC_RELAXED, __HIP_MEMORY_SCOPE_AGENT); }
__device__ __forceinline__ unsigned xb_xcc_id() { return (unsigned)__builtin_amdgcn_s_getreg((3 << 11) | 20) & 0xFu; }
#define XB_SPIN(cond, bar) do { unsigned _sp = 0; while (cond) { __builtin_amdgcn_s_sleep(1); \
    if ((++_sp & 255u) == 0u) { if (xb_ld(&(bar)[XB_TMO])) break; if (_sp > XB_SPIN_CAP) { atomicAdd(&(bar)[XB_TMO], 1u); break; } } } } while (0)

struct XcdBarrier {
    unsigned* bar; unsigned x;
    volatile LAS unsigned* st;
};

__device__ __forceinline__ XcdBarrier xcd_barrier_post(unsigned* bar, volatile LAS unsigned* st) {
    XcdBarrier b; b.bar = bar; b.x = xb_xcc_id(); b.st = st;
    if (threadIdx.x == 0) (void)xb_add(&bar[XB_XCNT(b.x)], 1u);
    return b;
}
__device__ __forceinline__ void xcd_barrier_complete(unsigned* bar, unsigned x, unsigned& nloc, unsigned& nx) {
    const unsigned G = gridDim.x * gridDim.y * gridDim.z;
    unsigned sum, cnt, mine, sp = 0u;
    for (;;) {
        sum = 0u; cnt = 0u; mine = 0u;
#pragma unroll
        for (unsigned j = 0; j < 16; ++j) { const unsigned c = xb_ld(&bar[XB_XCNT(j)]); sum += c; cnt += (c > 0u) ? 1u : 0u; mine = (j == x) ? c : mine; }
        if (sum == G) break;
        __builtin_amdgcn_s_sleep(1);
        if ((++sp & 255u) == 0u) { if (xb_ld(&bar[XB_TMO])) break; if (sp > XB_SPIN_CAP) { atomicAdd(&bar[XB_TMO], 1u); break; } }
    }
    nloc = mine > 0u ? mine : 1u; nx = cnt > 0u ? cnt : 1u;
}

__device__ __forceinline__ void xcd_barrier(const XcdBarrier& b) {
    asm volatile("s_waitcnt vmcnt(0)" ::: "memory");
    __syncthreads();
    if (threadIdx.x == 0) {
        unsigned* bar = b.bar;
        __builtin_amdgcn_s_waitcnt(0);
        unsigned nloc = b.st[0], nx = b.st[1];
        if (nloc == 0u) { xcd_barrier_complete(bar, b.x, nloc, nx); b.st[0] = nloc; b.st[1] = nx; }
        const unsigned old = xb_add(&bar[XB_XSUB(b.x)], 1u);
        const unsigned gen = old / nloc;
        if (old + 1u == (gen + 1u) * nloc) {
            __builtin_amdgcn_fence(__ATOMIC_RELEASE, "agent");
            asm volatile("s_waitcnt vmcnt(0)" ::: "memory");
            const unsigned og = xb_add(&bar[XB_TOP], 1u);
            const unsigned tg = og / nx;
            if (og + 1u == (tg + 1u) * nx) xb_add(&bar[XB_TOPGEN], 1u);
            else XB_SPIN(xb_ld(&bar[XB_TOPGEN]) == tg, bar);
            __builtin_amdgcn_fence(__ATOMIC_ACQUIRE, "agent");
            xb_add(&bar[XB_XGEN(b.x)], 1u);
            asm volatile("s_waitcnt vmcnt(0)" ::: "memory");
        } else {
            XB_SPIN(xb_ld(&bar[XB_XGEN(b.x)]) == gen, bar);
            __builtin_amdgcn_fence(__ATOMIC_ACQUIRE, "agent");
            asm volatile("s_waitcnt vmcnt(0)" ::: "memory");
        }
    }
    __syncthreads();
}
struct Frame {
    LAS unsigned char* lds;
    volatile LAS unsigned* MISC;
    gu32* ctl;
    int tid, lane, wave;
    int vcu, G;
    unsigned char* ws;
    const float* x_in; const int* positions; const float* norm_g;
    const float *ffn_wg, *ffn_wu, *ffn_wd;
    const float *mla_wa, *mla_qag, *mla_kvag, *mla_wuq, *mla_wukv, *mla_qg, *mla_kg, *mla_wo;
    const float *swa_wqkv, *swa_qg, *swa_kg, *swa_sink, *swa_wo;
    float* out;
};

__device__ __forceinline__ float wave_sum(float v) {
#pragma unroll
    for (int o = 1; o < 64; o <<= 1) v += __shfl_xor(v, o);
    return v;
}
__device__ __forceinline__ float sum16(float v) {
#pragma unroll
    for (int o = 1; o < 16; o <<= 1) v += __shfl_xor(v, o);
    return v;
}
__device__ __forceinline__ float bf2f_u(unsigned short x) { return __uint_as_float(((unsigned)x) << 16); }

__device__ __forceinline__ void transpose_item(const float* W, int K, int N, bf16* WT, int mode, LAS float* scr, int item, int lane) {
    const int nblk = N / 32, kb = item / nblk, nb = item % nblk, k0 = 64 * kb, n0 = 32 * nb;
    const int drow0 = (mode == 0) ? n0 : ((n0 >> 7) * 256 + (mode - 1) * 128 + (n0 & 127));
#pragma unroll 8
    for (int i = 0; i < 32; ++i) { const int kk = 2 * i + (lane >> 5); scr[kk * 33 + (lane & 31)] = W[(size_t)(k0 + kk) * N + n0 + (lane & 31)]; }
    LDS_WAIT(); asm volatile("" ::: "memory");
    const int c = lane & 7;
#pragma unroll
    for (int j = 0; j < 4; ++j) { const int n = (lane >> 3) + 8 * j; const LAS float* s = scr + (8 * c) * 33 + n;
        v4u o; o.x = pk2(s[0 * 33], s[1 * 33]); o.y = pk2(s[2 * 33], s[3 * 33]); o.z = pk2(s[4 * 33], s[5 * 33]); o.w = pk2(s[6 * 33], s[7 * 33]);
        *(GAS v4u*)(WT + (size_t)(drow0 + n) * K + k0 + 8 * c) = o; }
    LDS_WAIT(); asm volatile("" ::: "memory");
}

__device__ __forceinline__ void p_prologue(Frame& F) {
    LAS float* scr = (LAS float*)(F.lds + RING_OFF + F.wave * 16384);
    const int gw = F.vcu * NWAVES + F.wave, NGW = F.G * NWAVES;
    constexpr int I_GU = (DM / 64) * (DFF / 32), I_D = (DFF / 64) * (DM / 32), I_FFN = 2 * I_GU + I_D;
    constexpr int I_A = (DM / 64) * (MLA_NA / 32), I_UQ = (MLA_R / 64) * (MLA_NQ / 32), I_UKV = (MLA_R / 64) * (MLA_NKV / 32), I_O = (DM / 64) * (DM / 32), I_MLA = I_A + I_UQ + I_UKV + I_O;
    constexpr int I_QKV = (DM / 64) * (SWA_NQKV / 32), I_SWA = I_QKV + I_O;
    constexpr int NITEMS = 8 * I_FFN + 2 * I_MLA + 2 * I_SWA;
    for (int it = gw; it < NITEMS; it += NGW) {
        int r = it;
        if (r < 8 * I_FFN) { const int f = r / I_FFN; r -= f * I_FFN;
            bf16* wgu = (bf16*)(F.ws + WS_WFFN + (size_t)f * FFN_STRIDE); bf16* wd = (bf16*)(F.ws + WS_WFFN + (size_t)f * FFN_STRIDE + FFN_WD_OFF);
            if (r < I_GU) { transpose_item(F.ffn_wg + (size_t)f * DM * DFF, DM, DFF, wgu, 1, scr, r, F.lane); continue; } r -= I_GU;
            if (r < I_GU) { transpose_item(F.ffn_wu + (size_t)f * DM * DFF, DM, DFF, wgu, 2, scr, r, F.lane); continue; } r -= I_GU;
            transpose_item(F.ffn_wd + (size_t)f * DFF * DM, DFF, DM, wd, 0, scr, r, F.lane); continue; }
        r -= 8 * I_FFN;
        if (r < 2 * I_MLA) { const int j = r / I_MLA; r -= j * I_MLA; unsigned char* wb = F.ws + WS_WMLA + (size_t)j * MLA_STRIDE;
            if (r < I_A) { transpose_item(F.mla_wa + (size_t)j * DM * MLA_NA, DM, MLA_NA, (bf16*)wb, 0, scr, r, F.lane); continue; } r -= I_A;
            if (r < I_UQ) { transpose_item(F.mla_wuq + (size_t)j * MLA_R * MLA_NQ, MLA_R, MLA_NQ, (bf16*)(wb + MLA_WUQ_OFF), 0, scr, r, F.lane); continue; } r -= I_UQ;
            if (r < I_UKV) { transpose_item(F.mla_wukv + (size_t)j * MLA_R * MLA_NKV, MLA_R, MLA_NKV, (bf16*)(wb + MLA_WUKV_OFF), 0, scr, r, F.lane); continue; } r -= I_UKV;
            transpose_item(F.mla_wo + (size_t)j * DM * DM, DM, DM, (bf16*)(wb + MLA_WO_OFF), 0, scr, r, F.lane); continue; }
        r -= 2 * I_MLA;
        { const int j = r / I_SWA; r -= j * I_SWA; unsigned char* wb = F.ws + WS_WSWA + (size_t)j * SWA_STRIDE;
            if (r < I_QKV) { transpose_item(F.swa_wqkv + (size_t)j * DM * SWA_NQKV, DM, SWA_NQKV, (bf16*)wb, 0, scr, r, F.lane); continue; } r -= I_QKV;
            transpose_item(F.swa_wo + (size_t)j * DM * DM, DM, DM, (bf16*)(wb + SWA_WO_OFF), 0, scr, r, F.lane); }
    }
    { const int gt = F.vcu * (NWAVES * 64) + F.tid, NGT = F.G * NWAVES * 64;
      for (int i = gt; i < 2 * 49152; i += NGT) { const int j = i / 49152, r = i % 49152;
          *(GAS v4u*)(F.ws + WS_WMLA + (size_t)j * MLA_STRIDE + (size_t)MLA_NA * DM * 2 + (size_t)r * 16) = (v4u){0u, 0u, 0u, 0u}; }
      float* COS = (float*)(F.ws + WS_COS); float* SIN = (float*)(F.ws + WS_SIN);
      for (int i = gt; i < S_ * 32; i += NGT) { const int t = i >> 5, j = i & 31;
          const float inv_freq = 1.0f / powf(10000.0f, (float)(2 * j) * (1.0f / 64.0f));
          const float ang = (float)F.positions[t] * inv_freq;
          const double turns = (double)ang * 0.15915494309189533577; const double fr = turns - rint(turns);
          const float frf = (float)fr;
          COS[i] = __builtin_amdgcn_cosf(frf); SIN[i] = __builtin_amdgcn_sinf(frf); }
    }
}

__device__ __forceinline__ void p_norm(Frame& F, const float* x, const float* g, bf16* xn) {
    const int gw = F.vcu * NWAVES + F.wave, NGW = F.G * NWAVES;
    f32x4 gv[8];
#pragma unroll
    for (int j = 0; j < 8; ++j) gv[j] = ((const GAS f32x4*)g)[F.lane + 64 * j];
    for (int m = gw; m < S_; m += NGW) {
        const GAS f32x4* xr = (const GAS f32x4*)(x + (size_t)m * DM) + F.lane;
        f32x4 v[8]; float s2 = 0.f;
#pragma unroll
        for (int j = 0; j < 8; ++j) { v[j] = xr[64 * j]; s2 += (v[j].x * v[j].x + v[j].y * v[j].y) + (v[j].z * v[j].z + v[j].w * v[j].w); }
        const float rstd = 1.0f / sqrtf(wave_sum(s2) * (1.f / DM) + RMS_EPS);
        GAS unsigned long long* o8 = (GAS unsigned long long*)(xn + (size_t)m * DM) + F.lane;
#pragma unroll
        for (int j = 0; j < 8; ++j) { const f32x4 y = v[j] * rstd * gv[j]; o8[64 * j] = (unsigned long long)pk2(y.x, y.y) | ((unsigned long long)pk2(y.z, y.w) << 32); }
    }
}

__device__ __forceinline__ void p_mla_mid(Frame& F, const float* H, const float* qag, const float* kvag, bf16* cqn, bf16* ckvn) {
    const int gw = F.vcu * NWAVES + F.wave, NGW = F.G * NWAVES;
    const f32x4 ga0 = ((const GAS f32x4*)qag)[F.lane], ga1 = ((const GAS f32x4*)qag)[64 + F.lane], gb0 = ((const GAS f32x4*)kvag)[F.lane], gb1 = ((const GAS f32x4*)kvag)[64 + F.lane];
    for (int m = gw; m < S_; m += NGW) {
        const GAS f32x4* hr = (const GAS f32x4*)(H + (size_t)m * MLA_NA_PAD) + F.lane;
        const f32x4 a0 = hr[0], a1 = hr[64], b0 = hr[128], b1 = hr[192];
        const float sa = wave_sum((a0.x * a0.x + a0.y * a0.y) + (a0.z * a0.z + a0.w * a0.w) + (a1.x * a1.x + a1.y * a1.y) + (a1.z * a1.z + a1.w * a1.w));
        const float sb = wave_sum((b0.x * b0.x + b0.y * b0.y) + (b0.z * b0.z + b0.w * b0.w) + (b1.x * b1.x + b1.y * b1.y) + (b1.z * b1.z + b1.w * b1.w));
        const float ra = 1.0f / sqrtf(sa * (1.f / 512.f) + RMS_EPS), rb = 1.0f / sqrtf(sb * (1.f / 512.f) + RMS_EPS);
        GAS unsigned long long* oa = (GAS unsigned long long*)(cqn + (size_t)m * MLA_R) + F.lane; GAS unsigned long long* ob = (GAS unsigned long long*)(ckvn + (size_t)m * MLA_R) + F.lane;
        { const f32x4 y = a0 * ra * ga0; oa[0] = (unsigned long long)pk2(y.x, y.y) | ((unsigned long long)pk2(y.z, y.w) << 32); }
        { const f32x4 y = a1 * ra * ga1; oa[64] = (unsigned long long)pk2(y.x, y.y) | ((unsigned long long)pk2(y.z, y.w) << 32); }
        { const f32x4 y = b0 * rb * gb0; ob[0] = (unsigned long long)pk2(y.x, y.y) | ((unsigned long long)pk2(y.z, y.w) << 32); }
        { const f32x4 y = b1 * rb * gb1; ob[64] = (unsigned long long)pk2(y.x, y.y) | ((unsigned long long)pk2(y.z, y.w) << 32); }
    }
}

__device__ __forceinline__ void p_mla_prep(Frame& F, bf16* Q, const bf16* KV, const float* H, const float* qg, const float* kg, bf16* KN) {
    const int gw = F.vcu * NWAVES + F.wave, NGW = F.G * NWAVES; const int i16 = F.lane & 15, hsub = F.lane >> 4;
    const float C2 = 1.4426950408889634f * 0.07216878364870322f;
    const float* COS = (const float*)(F.ws + WS_COS); const float* SIN = (const float*)(F.ws + WS_SIN);
    f32x4 qg0 = *(const f32x4*)(qg + 8 * i16), qg1 = *(const f32x4*)(qg + 8 * i16 + 4), kg0 = *(const f32x4*)(kg + 8 * i16), kg1 = *(const f32x4*)(kg + 8 * i16 + 4);
    const float qgr[4] = {qg[128 + 2 * i16], qg[129 + 2 * i16], qg[160 + 2 * i16], qg[161 + 2 * i16]};
    const float kgr[4] = {kg[128 + 2 * i16], kg[129 + 2 * i16], kg[160 + 2 * i16], kg[161 + 2 * i16]};
    for (int t = gw; t < S_; t += NGW) {
        const float c0 = COS[t * 32 + 2 * i16], c1 = COS[t * 32 + 2 * i16 + 1], s0 = SIN[t * 32 + 2 * i16], s1 = SIN[t * 32 + 2 * i16 + 1];
        const float* kpe = H + (size_t)t * MLA_NA_PAD + 1024;
        const float ka0 = kpe[2 * i16], ka1 = kpe[2 * i16 + 1], kb0 = kpe[32 + 2 * i16], kb1 = kpe[33 + 2 * i16];
        const float ss_pe = sum16((ka0 * ka0 + ka1 * ka1) + (kb0 * kb0 + kb1 * kb1));
#pragma unroll 1
        for (int pass = 0; pass < 4; ++pass) { const int h = pass * 4 + hsub;
            bf16* qp = Q + (size_t)t * MLA_NQ + h * 192;
            const v4u qn = *(const GAS v4u*)(qp + 8 * i16); const unsigned qa = *(const GAS unsigned*)(qp + 128 + 2 * i16), qb = *(const GAS unsigned*)(qp + 160 + 2 * i16);
            float f[8] = {bf2f_u((unsigned short)qn.x), bf2f_u((unsigned short)(qn.x >> 16)), bf2f_u((unsigned short)qn.y), bf2f_u((unsigned short)(qn.y >> 16)),
                          bf2f_u((unsigned short)qn.z), bf2f_u((unsigned short)(qn.z >> 16)), bf2f_u((unsigned short)qn.w), bf2f_u((unsigned short)(qn.w >> 16))};
            const float a0 = bf2f_u((unsigned short)qa), a1 = bf2f_u((unsigned short)(qa >> 16)), b0 = bf2f_u((unsigned short)qb), b1 = bf2f_u((unsigned short)(qb >> 16));
            float ss = (a0 * a0 + a1 * a1) + (b0 * b0 + b1 * b1);
#pragma unroll
            for (int e = 0; e < 8; ++e) ss += f[e] * f[e];
            const float rq = C2 / sqrtf(sum16(ss) * (1.f / 192.f) + RMS_EPS);
            { v4u o; o.x = pk2(f[0] * rq * qg0.x, f[1] * rq * qg0.y); o.y = pk2(f[2] * rq * qg0.z, f[3] * rq * qg0.w); o.z = pk2(f[4] * rq * qg1.x, f[5] * rq * qg1.y); o.w = pk2(f[6] * rq * qg1.z, f[7] * rq * qg1.w);
              *(GAS v4u*)(qp + 8 * i16) = o; }
            { const float x0 = a0 * rq * qgr[0], x1 = a1 * rq * qgr[1], y0 = b0 * rq * qgr[2], y1 = b1 * rq * qgr[3];
              *(GAS unsigned*)(qp + 128 + 2 * i16) = pk2(x0 * c0 - y0 * s0, x1 * c1 - y1 * s1); *(GAS unsigned*)(qp + 160 + 2 * i16) = pk2(y0 * c0 + x0 * s0, y1 * c1 + x1 * s1); }
            const v4u kn = *(const GAS v4u*)(KV + (size_t)t * MLA_NKV + h * 256 + 8 * i16);
            float kf[8] = {bf2f_u((unsigned short)kn.x), bf2f_u((unsigned short)(kn.x >> 16)), bf2f_u((unsigned short)kn.y), bf2f_u((unsigned short)(kn.y >> 16)),
                           bf2f_u((unsigned short)kn.z), bf2f_u((unsigned short)(kn.z >> 16)), bf2f_u((unsigned short)kn.w), bf2f_u((unsigned short)(kn.w >> 16))};
            float sk = 0.f;
#pragma unroll
            for (int e = 0; e < 8; ++e) sk += kf[e] * kf[e];
            const float rk = 1.0f / sqrtf((sum16(sk) + ss_pe) * (1.f / 192.f) + RMS_EPS);
            bf16* kp = KN + (size_t)t * MLA_NQ + h * 192;
            { v4u o; o.x = pk2(kf[0] * rk * kg0.x, kf[1] * rk * kg0.y); o.y = pk2(kf[2] * rk * kg0.z, kf[3] * rk * kg0.w); o.z = pk2(kf[4] * rk * kg1.x, kf[5] * rk * kg1.y); o.w = pk2(kf[6] * rk * kg1.z, kf[7] * rk * kg1.w);
              *(GAS v4u*)(kp + 8 * i16) = o; }
            { const float x0 = ka0 * rk * kgr[0], x1 = ka1 * rk * kgr[1], y0 = kb0 * rk * kgr[2], y1 = kb1 * rk * kgr[3];
              *(GAS unsigned*)(kp + 128 + 2 * i16) = pk2(x0 * c0 - y0 * s0, x1 * c1 - y1 * s1); *(GAS unsigned*)(kp + 160 + 2 * i16) = pk2(y0 * c0 + x0 * s0, y1 * c1 + x1 * s1); }
        }
    }
}

struct Ctx { int pid, lo, hi; XcdBarrier bar; };
#define PH_ON() (C.pid >= C.lo && C.pid < C.hi)
#define PH_END() do { if (C.pid >= C.lo && C.pid + 1 < C.hi) xcd_barrier(C.bar); ++C.pid; } while (0)
#define WS_PTRS() bf16* XN = (bf16*)(F.ws + WS_XN); bf16* ACT = (bf16*)(F.ws + WS_ACT); float* H = (float*)(F.ws + WS_H); \
    bf16* CQN = (bf16*)(F.ws + WS_CQN); bf16* CKVN = (bf16*)(F.ws + WS_CKVN); bf16* Q = (bf16*)(F.ws + WS_Q); bf16* KV = (bf16*)(F.ws + WS_KV); bf16* KN = (bf16*)(F.ws + WS_KN); bf16* OB = (bf16*)(F.ws + WS_O); \
    (void)XN; (void)ACT; (void)H; (void)CQN; (void)CKVN; (void)Q; (void)KV; (void)KN; (void)OB

__device__ __forceinline__ void ffn_block(Frame& F, Ctx& C, int L, int part) {
    WS_PTRS();
    const float* gL = F.norm_g + (size_t)L * 3 * DM;
    const int f = L * 2 + (part >> 1);
    const float* xsrc = (L == 0 && part == 0) ? F.x_in : F.out;
    if (PH_ON()) p_norm(F, xsrc, gL + part * DM, XN);
    PH_END();
    if (PH_ON()) { pg8::Gemm g{XN, (const bf16*)(F.ws + WS_WFFN + (size_t)f * FFN_STRIDE), S_, 2 * DFF, DM}; pg8::StaticOrder So; So.init(S_, 2 * DFF, F.G, (int)blockIdx.x);
        pg8::EpiSwiGLU E{ACT, DFF};
        pg8::gemm_phase<pg8::EpiSwiGLU, pg8::StaticOrder, true, true>(F.lds + RING_OFF, g, So, E); }
    PH_END();
    if (PH_ON()) { pg8::Gemm g{ACT, (const bf16*)(F.ws + WS_WFFN + (size_t)f * FFN_STRIDE + FFN_WD_OFF), S_, DM, DFF}; pg8::StaticOrder So; So.init(S_, DM, F.G, (int)blockIdx.x);
        pg8::EpiResid E{xsrc, F.out, DM, 0.5f};
        pg8::gemm_phase<pg8::EpiResid, pg8::StaticOrder, true, true>(F.lds + RING_OFF, g, So, E); }
    PH_END();
}
__device__ __forceinline__ void mla_block(Frame& F, Ctx& C, int L) {
    WS_PTRS();
    const float* gL = F.norm_g + (size_t)L * 3 * DM;
    const int j = L >> 1; unsigned char* wb = F.ws + WS_WMLA + (size_t)j * MLA_STRIDE;
    if (PH_ON()) p_norm(F, F.out, gL + DM, XN);
    PH_END();
    if (PH_ON()) { pg8::Gemm g{XN, (const bf16*)wb, S_, MLA_NA_PAD, DM}; pg8::StaticOrder So; So.init(S_, MLA_NA_PAD, F.G, (int)blockIdx.x);
        pg8::EpiF32 E{H, MLA_NA_PAD};
        pg8::gemm_phase<pg8::EpiF32, pg8::StaticOrder, true, true>(F.lds + RING_OFF, g, So, E); }
    PH_END();
    if (PH_ON()) p_mla_mid(F, H, F.mla_qag + j * MLA_R, F.mla_kvag + j * MLA_R, CQN, CKVN);
    PH_END();
    if (PH_ON()) {
        { pg8::Gemm g{CQN, (const bf16*)(wb + MLA_WUQ_OFF), S_, MLA_NQ, MLA_R}; pg8::StaticOrder So; So.init(S_, MLA_NQ, F.G, (int)blockIdx.x);
          pg8::EpiBf16<0> E{Q, MLA_NQ, nullptr, 0, 0, 1.f};
          pg8::gemm_phase<pg8::EpiBf16<0>, pg8::StaticOrder, true, true>(F.lds + RING_OFF, g, So, E); }
        { pg8::Gemm g{CKVN, (const bf16*)(wb + MLA_WUKV_OFF), S_, MLA_NKV, MLA_R}; pg8::StaticOrder So; So.init(S_, MLA_NKV, F.G, (int)blockIdx.x);
          pg8::EpiBf16<0> E{KV, MLA_NKV, nullptr, 0, 0, 1.f};
          pg8::gemm_phase<pg8::EpiBf16<0>, pg8::StaticOrder, true, true>(F.lds + RING_OFF, g, So, E); }
    }
    PH_END();
    if (PH_ON()) p_mla_prep(F, Q, KV, H, F.mla_qg + j * 192, F.mla_kg + j * 192, KN);
    PH_END();
    if (PH_ON()) {
        if (!TEST_NO_MLA) for (int u = F.vcu; u < 16 * 32; u += F.G) att::mla::unit(F.lds + RING_OFF, (LAS float*)(F.lds + WSCR_OFF), Q, KN, KV, OB, u >> 5, u & 31);
    }
    PH_END();
    if (PH_ON()) { pg8::Gemm g{OB, (const bf16*)(wb + MLA_WO_OFF), S_, DM, DM}; pg8::StaticOrder So; So.init(S_, DM, F.G, (int)blockIdx.x);
        pg8::EpiResid E{F.out, F.out, DM, 1.0f};
        pg8::gemm_phase<pg8::EpiResid, pg8::StaticOrder, true, true>(F.lds + RING_OFF, g, So, E); }
    PH_END();
}
__device__ __forceinline__ void swa_block(Frame& F, Ctx& C, int L) {
    WS_PTRS();
    const float* gL = F.norm_g + (size_t)L * 3 * DM;
    const int j = L >> 1; unsigned char* wb = F.ws + WS_WSWA + (size_t)j * SWA_STRIDE;
    if (PH_ON()) p_norm(F, F.out, gL + DM, XN);
    PH_END();
    if (PH_ON()) { pg8::Gemm g{XN, (const bf16*)wb, S_, SWA_NQKV, DM}; pg8::StaticOrder So; So.init(S_, SWA_NQKV, F.G, (int)blockIdx.x);
        pg8::EpiBf16<0> E{Q, SWA_NQKV, nullptr, 0, 0, 1.f};
        pg8::gemm_phase<pg8::EpiBf16<0>, pg8::StaticOrder, true, true>(F.lds + RING_OFF, g, So, E); }
    PH_END();
    if (PH_ON()) {
        for (int u = F.vcu; u < 8 * 32; u += F.G)
            att::swa::super_unit(F.lds + RING_OFF, (LAS float*)(F.lds + POSK_OFF), (LAS float*)(F.lds + WSCR_OFF), Q, F.positions, F.swa_qg + j * 64, F.swa_kg + j * 64, F.swa_sink + j * 32, OB, u >> 5, u & 31);
    }
    PH_END();
    if (PH_ON()) { pg8::Gemm g{OB, (const bf16*)(wb + SWA_WO_OFF), S_, DM, DM}; pg8::StaticOrder So; So.init(S_, DM, F.G, (int)blockIdx.x);
        pg8::EpiResid E{F.out, F.out, DM, 1.0f};
        pg8::gemm_phase<pg8::EpiResid, pg8::StaticOrder, true, true>(F.lds + RING_OFF, g, So, E); }
    PH_END();
}

struct Args { const void* in[19]; float* out; unsigned char* ws; int ph_lo, ph_hi; };
__global__ void __launch_bounds__(NWAVES * 64, 2) mk_fwd(Args args) {
    extern __shared__ __attribute__((aligned(16))) unsigned char lds[];
    Frame F;
    F.lds = (LAS unsigned char*)lds;
    F.MISC = (volatile LAS unsigned*)(F.lds + MISC_OFF);
    F.tid = threadIdx.x; F.lane = F.tid & 63; F.wave = __builtin_amdgcn_readfirstlane(F.tid >> 6);
    F.G = gridDim.x; { const int bx = blockIdx.x; F.vcu = (F.G % 8 == 0) ? (bx % 8) * (F.G / 8) + bx / 8 : bx; }
    F.ws = args.ws; F.ctl = (gu32*)(args.ws + WS_CTL);
    F.x_in = (const float*)args.in[0]; F.positions = (const int*)args.in[1]; F.norm_g = (const float*)args.in[2];
    F.ffn_wg = (const float*)args.in[3]; F.ffn_wu = (const float*)args.in[4]; F.ffn_wd = (const float*)args.in[5];
    F.mla_wa = (const float*)args.in[6]; F.mla_qag = (const float*)args.in[7]; F.mla_kvag = (const float*)args.in[8]; F.mla_wuq = (const float*)args.in[9]; F.mla_wukv = (const float*)args.in[10];
    F.mla_qg = (const float*)args.in[11]; F.mla_kg = (const float*)args.in[12]; F.mla_wo = (const float*)args.in[13];
    F.swa_wqkv = (const float*)args.in[14]; F.swa_qg = (const float*)args.in[15]; F.swa_kg = (const float*)args.in[16]; F.swa_sink = (const float*)args.in[17]; F.swa_wo = (const float*)args.in[18];
    F.out = args.out;
    for (int u = F.tid; u < (LDS_BYTES - LDSCTL_OFF) / 4; u += NWAVES * 64) ((LAS unsigned*)(F.lds + LDSCTL_OFF))[u] = 0u;
    __syncthreads();
    Ctx C; C.pid = 0; C.lo = args.ph_lo; C.hi = args.ph_hi;
    C.bar.bar = (unsigned*)(F.ctl + CW_BAR); C.bar.x = 0; C.bar.st = nullptr;
    if (!MK_PER_PHASE) C.bar = xcd_barrier_post((unsigned*)(F.ctl + CW_BAR), F.MISC + 8);

    if (PH_ON()) p_prologue(F);
    PH_END();
#if TEST_PROG == 0
#pragma unroll 1
    for (int lp = 0; lp < 2; ++lp) {
        ffn_block(F, C, 2 * lp, 0); mla_block(F, C, 2 * lp); ffn_block(F, C, 2 * lp, 2);
        ffn_block(F, C, 2 * lp + 1, 0); swa_block(F, C, 2 * lp + 1); ffn_block(F, C, 2 * lp + 1, 2);
    }
#elif TEST_PROG == 6
    ffn_block(F, C, 0, 0); mla_block(F, C, 0); ffn_block(F, C, 0, 2);
    ffn_block(F, C, 1, 0); swa_block(F, C, 1); ffn_block(F, C, 1, 2);
    ffn_block(F, C, 2, 0); mla_block(F, C, 2); ffn_block(F, C, 2, 2);
    ffn_block(F, C, 3, 0); swa_block(F, C, 3); ffn_block(F, C, 3, 2);
#elif TEST_PROG == 1
    ffn_block(F, C, 0, 0);
#elif TEST_PROG == 2
    ffn_block(F, C, 0, 0); ffn_block(F, C, 0, 2);
#elif TEST_PROG == 3
    mla_block(F, C, 0);
#elif TEST_PROG == 4
    swa_block(F, C, 1);
#elif TEST_PROG == 5
    for (int lp = 0; lp < 2; ++lp) { ffn_block(F, C, 2 * lp, 0); }
#endif
}
#undef PH_ON
#undef PH_END
#undef WS_PTRS
constexpr int N_PHASES = 1 + 8 * 3 + 2 * 7 + 2 * 4;

extern "C" void kernel_launch(void* const* d_in, const int* in_sizes, int n_in, void* d_out, int out_size, void* d_ws, size_t ws_size, hipStream_t stream) {
    static int grid = 0;
    if (grid == 0) {
        if (n_in != 19 || in_sizes[0] != S_ * DM || out_size != S_ * DM || ws_size < WS_END) { fprintf(stderr, "kernel_launch: shape mismatch (n_in %d, in0 %d, out %d, ws %zu < %zu)\n", n_in, n_in > 0 ? in_sizes[0] : -1, out_size, ws_size, (size_t)WS_END); grid = -1; return; }
        int dev = 0, cus = 0, per_cu = 0;
        if (hipGetDevice(&dev) != hipSuccess || hipDeviceGetAttribute(&cus, hipDeviceAttributeMultiprocessorCount, dev) != hipSuccess) { fprintf(stderr, "kernel_launch: device query failed\n"); grid = -1; return; }
        if (hipFuncSetAttribute((const void*)mk_fwd, hipFuncAttributeMaxDynamicSharedMemorySize, LDS_BYTES) != hipSuccess) { fprintf(stderr, "kernel_launch: hipFuncSetAttribute failed\n"); grid = -1; return; }
        if (hipOccupancyMaxActiveBlocksPerMultiprocessor(&per_cu, (const void*)mk_fwd, NWAVES * 64, LDS_BYTES) != hipSuccess || per_cu < 1)
            fprintf(stderr, "kernel_launch: note: occupancy query reports %d workgroups per CU\n", per_cu);
        (void)hipGetLastError();
        grid = cus;
    }
    if (grid < 0) return;
    if (hipMemsetAsync((char*)d_ws + WS_CTL, 0, CTL_ZERO_BYTES, stream) != hipSuccess) { fprintf(stderr, "kernel_launch: memset failed\n"); return; }
    Args a{};
    for (int i = 0; i < 19; ++i) a.in[i] = d_in[i];
    a.out = (float*)d_out; a.ws = (unsigned char*)d_ws;
#if MK_PER_PHASE
    for (int p = 0; p < N_PHASES; ++p) { a.ph_lo = p; a.ph_hi = p + 1; hipLaunchKernelGGL(mk_fwd, dim3(grid), dim3(NWAVES * 64), LDS_BYTES, stream, a); }
#else
    a.ph_lo = 0; a.ph_hi = N_PHASES;
    hipLaunchKernelGGL(mk_fwd, dim3(grid), dim3(NWAVES * 64), LDS_BYTES, stream, a);
#endif
    const hipError_t le = hipPeekAtLastError();
    if (le != hipSuccess) fprintf(stderr, "kernel_launch: launch failed: %s\n", hipGetErrorName(le));
}
```

```cpp
#include <hip/hip_runtime.h>
#include <cstdio>
#include <cstdint>
namespace pg8 {
#define PG8_LAS __attribute__((address_space(3)))
typedef unsigned short bf16_t;
typedef short bf16x8 __attribute__((ext_vector_type(8)));
typedef float f32x4 __attribute__((ext_vector_type(4)));
typedef unsigned u32x4 __attribute__((ext_vector_type(4)));
constexpr int BM = 256, BK = 64, HALF = 128, HTB = HALF * BK * 2  , STAGE_BYTES = 8 * HTB, NXCD = 8, WGM = 8;

__host__ __device__ __forceinline__ int lds_byte(int r, int c) { const int st = (r >> 4) * 2 + (c >> 5), rr = r & 15, cc = c & 31, ob = rr * 64 + cc * 2; return st * 1024 + (ob ^ (((ob >> 9) & 1) << 5)); }
__host__ __device__ __forceinline__ void stage_rc(int b, int& R, int& C) { const int st = b / 1024, sb = b % 1024, swz = sb ^ (((sb >> 9) & 1) << 5); R = (st >> 1) * 16 + swz / 64; C = (st & 1) * 32 + (swz % 64) / 2; }
__host__ __device__ __forceinline__ int perm32(int rho) { const int n = rho >> 4, i = rho & 15; return 8 * (i >> 2) + 4 * n + (i & 3); }

template <class T> __device__ __forceinline__ void st16(void* p, const T& v) { static_assert(sizeof(T) == 16, "st16"); *(T*)p = v; }
#define PG8_ST16(p, v) st16((void*)(p), (v))
struct Unit { int pm, pn; };
struct Gemm { const bf16_t* A; const bf16_t* Bt; int M, N, K; };

struct StaticOrder {
    int nM, nN, nwg, G, c;
    __host__ __device__ void init(int M, int N, int G_, int c_) { nM = M / BM; nN = N / BM; nwg = nM * nN; G = G_; c = c_; }
    __host__ __device__ bool next(int i, Unit& u) const {
        const long L = (long)i * G + c; if (L >= nwg) return false;
        int wgid = (int)L; { const int q = nwg / NXCD, r = nwg % NXCD, xcd = wgid % NXCD, off = wgid / NXCD; wgid = (xcd < r ? xcd * (q + 1) : r * (q + 1) + (xcd - r) * q) + off; }
        const int nig = WGM * nN, gid = wgid / nig, fm = gid * WGM, gsz = (nM - fm) < WGM ? (nM - fm) : WGM;
        u.pm = fm + ((wgid % nig) % gsz); u.pn = (wgid % nig) / gsz; return true;
    }
    __device__ __forceinline__ void a_ready(const Unit&) const {}
    __device__ __forceinline__ void done(const Unit&) const {}
};

__device__ __forceinline__ unsigned cvt_pk_bf16(float lo, float hi) { unsigned r; asm volatile("v_cvt_pk_bf16_f32 %0, %1, %2" : "=v"(r) : "v"(lo), "v"(hi)); return r; }
typedef float f32x2 __attribute__((ext_vector_type(2)));
__device__ __forceinline__ f32x2 gelu_pk(f32x2 v) {
    const f32x2 av = __builtin_elementwise_abs(v), d = av * 0.2316418882f + 1.0f;
    f32x2 t; t.x = __builtin_amdgcn_rcpf(d.x); t.y = __builtin_amdgcn_rcpf(d.y);
    f32x2 q = t * 0.5307027145f + (-0.7265760135f); q = q * t + 0.7107068705f; q = q * t + (-0.142248368f); q = q * t + 0.127414796f; q = q * t;
    const f32x2 s = (v * v) * (-0.72134752044f);
    f32x2 e; e.x = __builtin_amdgcn_exp2f(s.x); e.y = __builtin_amdgcn_exp2f(s.y);
    const f32x2 m = v * (q * e), r = v - m;
    f32x2 o; o.x = v.x < 0.f ? m.x : r.x; o.y = v.y < 0.f ? m.y : r.y; return o;
}

template <int ACT  > struct EpiBf16 {
    static constexpr bool PERM = true, AFTER_DRAIN = false; static_assert(ACT == 0 || ACT == 1, "EpiBf16: ACT is 0 (none) or 1 (gelu_pk)");
    bf16_t* O; int ldc; const float* bias; int split_cols; size_t split_stride; float scale0;
    __device__ __forceinline__ void operator()(const f32x4 (&acc)[2][2][4][2], const Unit& u, int wr, int wc, int fr, int fq) const {
        const int row0 = u.pm * BM + wr * 64 + fr; int colt = u.pn * BM; bf16_t* base = O;
        float sc = 1.f; if (split_cols) { const int t = colt / split_cols; base += (size_t)t * split_stride; colt -= t * split_cols; if (t == 0) sc = scale0; }
        const int col0 = colt + wc * 32 + 8 * fq, bcol0 = u.pn * BM + wc * 32 + 8 * fq;
        f32x4 bv[2][2];
#pragma unroll
        for (int bj = 0; bj < 2; ++bj)
#pragma unroll
            for (int n = 0; n < 2; ++n) bv[bj][n] = bias ? *(const f32x4*)(bias + bcol0 + bj * HALF + 4 * n) : (f32x4){0.f, 0.f, 0.f, 0.f};
#pragma unroll
        for (int ai = 0; ai < 2; ++ai)
#pragma unroll
            for (int m = 0; m < 4; ++m) { bf16_t* rowp = base + (size_t)(row0 + ai * HALF + m * 16) * ldc + col0;
#pragma unroll
                for (int bj = 0; bj < 2; ++bj) { f32x4 v0 = acc[ai][bj][m][0] + bv[bj][0], v1 = acc[ai][bj][m][1] + bv[bj][1];
                    if (ACT == 1) { f32x2 a = gelu_pk((f32x2){v0[0], v0[1]}), b = gelu_pk((f32x2){v0[2], v0[3]}), c = gelu_pk((f32x2){v1[0], v1[1]}), d = gelu_pk((f32x2){v1[2], v1[3]});
                        v0 = (f32x4){a.x, a.y, b.x, b.y}; v1 = (f32x4){c.x, c.y, d.x, d.y}; }
                    v0 = v0 * sc; v1 = v1 * sc; u32x4 w; w.x = cvt_pk_bf16(v0[0], v0[1]); w.y = cvt_pk_bf16(v0[2], v0[3]); w.z = cvt_pk_bf16(v1[0], v1[1]); w.w = cvt_pk_bf16(v1[2], v1[3]);
                    PG8_ST16(rowp + bj * HALF, w); } }
    }
};
struct EpiF32 {
    static constexpr bool PERM = false, AFTER_DRAIN = false;
    float* C; int ldc;
    __device__ __forceinline__ void operator()(const f32x4 (&acc)[2][2][4][2], const Unit& u, int wr, int wc, int fr, int fq) const {
        const int row0 = u.pm * BM + wr * 64 + fr, col0 = u.pn * BM + wc * 32 + 4 * fq;
#pragma unroll
        for (int ai = 0; ai < 2; ++ai)
#pragma unroll
            for (int m = 0; m < 4; ++m) { float* rowp = C + (size_t)(row0 + ai * HALF + m * 16) * ldc + col0;
#pragma unroll
                for (int bj = 0; bj < 2; ++bj)
#pragma unroll
                    for (int n = 0; n < 2; ++n) PG8_ST16(rowp + bj * HALF + n * 16, acc[ai][bj][m][n]); }
    }
};
typedef _Float16 f16x8_t __attribute__((ext_vector_type(8)));
template <bool RF, bool OF> struct EpiResid {
    static constexpr bool PERM = true, AFTER_DRAIN = false;
    const void* res; void* out; int ldc; float alpha;
    struct R8 { f32x4 a, b; };
    __device__ __forceinline__ static R8 ld8(const void* base, size_t off) { R8 r;
        if (RF) { const f16x8_t h = *(const f16x8_t*)((const _Float16*)base + off); r.a = (f32x4){(float)h[0], (float)h[1], (float)h[2], (float)h[3]}; r.b = (f32x4){(float)h[4], (float)h[5], (float)h[6], (float)h[7]}; }
        else { r.a = *(const f32x4*)((const float*)base + off); r.b = *(const f32x4*)((const float*)base + off + 4); }
        return r; }
    __device__ __forceinline__ static void st8(void* base, size_t off, const f32x4& a, const f32x4& b) {
        if (OF) { f16x8_t h = {(_Float16)a[0], (_Float16)a[1], (_Float16)a[2], (_Float16)a[3], (_Float16)b[0], (_Float16)b[1], (_Float16)b[2], (_Float16)b[3]}; *(f16x8_t*)((_Float16*)base + off) = h; }
        else { *(f32x4*)((float*)base + off) = a; *(f32x4*)((float*)base + off + 4) = b; } }
    __device__ __forceinline__ void operator()(const f32x4 (&acc)[2][2][4][2], const Unit& u, int wr, int wc, int fr, int fq) const {
        const int row0 = u.pm * BM + wr * 64 + fr, col0 = u.pn * BM + wc * 32 + 8 * fq;
        R8 cur[2], nxt[2];
        { const size_t off = (size_t)row0 * ldc + col0; cur[0] = ld8(res, off); cur[1] = ld8(res, off + HALF); }
#pragma unroll
        for (int gidx = 0; gidx < 8; ++gidx) { const int ai = gidx >> 2, m = gidx & 3;
            const size_t off = (size_t)(row0 + ai * HALF + m * 16) * ldc + col0;
            if (gidx < 7) { const int ai2 = (gidx + 1) >> 2, m2 = (gidx + 1) & 3; const size_t off2 = (size_t)(row0 + ai2 * HALF + m2 * 16) * ldc + col0;
                nxt[0] = ld8(res, off2); nxt[1] = ld8(res, off2 + HALF); }
#pragma unroll
            for (int bj = 0; bj < 2; ++bj) st8(out, off + bj * HALF, cur[bj].a + acc[ai][bj][m][0] * alpha, cur[bj].b + acc[ai][bj][m][1] * alpha);
            cur[0] = nxt[0]; cur[1] = nxt[1];
        }
    }
};
struct EpiSwiGLU {
    static constexpr bool PERM = true, AFTER_DRAIN = false;
    bf16_t* O; int ldc;
    __device__ __forceinline__ static float silu_mul(float g, float u) { const float e = __builtin_amdgcn_exp2f(g * -1.4426950408889634f); return g * u * __builtin_amdgcn_rcpf(1.0f + e); }
    __device__ __forceinline__ void operator()(const f32x4 (&acc)[2][2][4][2], const Unit& u, int wr, int wc, int fr, int fq) const {
        const int row0 = u.pm * BM + wr * 64 + fr, col0 = u.pn * HALF + wc * 32 + 8 * fq;
#pragma unroll
        for (int ai = 0; ai < 2; ++ai)
#pragma unroll
            for (int m = 0; m < 4; ++m) { bf16_t* rowp = O + (size_t)(row0 + ai * HALF + m * 16) * ldc + col0;
                const f32x4 g0 = acc[ai][0][m][0], g1 = acc[ai][0][m][1], u0 = acc[ai][1][m][0], u1 = acc[ai][1][m][1];
                u32x4 w; w.x = cvt_pk_bf16(silu_mul(g0[0], u0[0]), silu_mul(g0[1], u0[1])); w.y = cvt_pk_bf16(silu_mul(g0[2], u0[2]), silu_mul(g0[3], u0[3]));
                w.z = cvt_pk_bf16(silu_mul(g1[0], u1[0]), silu_mul(g1[1], u1[1])); w.w = cvt_pk_bf16(silu_mul(g1[2], u1[2]), silu_mul(g1[3], u1[3]));
                PG8_ST16(rowp, w); }
    }
};

constexpr float RMS_EPS_ = 1e-6f;
__device__ __forceinline__ void lds_rstd(float (&rs)[2][4], const PG8_LAS float* tab, const Unit& u, int wr, int fr) {
    const PG8_LAS float* p = tab + (u.pm & 7) * BM + wr * 64 + fr;
#pragma unroll
    for (int ai = 0; ai < 2; ++ai)
#pragma unroll
        for (int m = 0; m < 4; ++m) rs[ai][m] = p[ai * HALF + m * 16];
}
struct EpiBf16R {
    static constexpr bool PERM = true, AFTER_DRAIN = false;
    bf16_t* O; int ldc; const PG8_LAS float* rstab;
    __device__ __forceinline__ void operator()(const f32x4 (&acc)[2][2][4][2], const Unit& u, int wr, int wc, int fr, int fq) const {
        const int row0 = u.pm * BM + wr * 64 + fr, col0 = u.pn * BM + wc * 32 + 8 * fq;
        float rs[2][4]; lds_rstd(rs, rstab, u, wr, fr);
#pragma unroll
        for (int ai = 0; ai < 2; ++ai)
#pragma unroll
            for (int m = 0; m < 4; ++m) { bf16_t* rowp = O + (size_t)(row0 + ai * HALF + m * 16) * ldc + col0; const float r = rs[ai][m];
#pragma unroll
                for (int bj = 0; bj < 2; ++bj) { const f32x4 v0 = acc[ai][bj][m][0] * r, v1 = acc[ai][bj][m][1] * r;
                    u32x4 w; w.x = cvt_pk_bf16(v0[0], v0[1]); w.y = cvt_pk_bf16(v0[2], v0[3]); w.z = cvt_pk_bf16(v1[0], v1[1]); w.w = cvt_pk_bf16(v1[2], v1[3]);
                    *(u32x4*)(rowp + bj * HALF) = w; } }
    }
};
struct EpiMlaA {
    static constexpr bool PERM = true, AFTER_DRAIN = false;
    bf16_t* cq; bf16_t* ckv; float* kpe; float* ssa;
    __device__ __forceinline__ void operator()(const f32x4 (&acc)[2][2][4][2], const Unit& u, int wr, int wc, int fr, int fq) const {
        const int row0 = u.pm * BM + wr * 64 + fr, colw = wc * 32 + 8 * fq;
#pragma unroll
        for (int ai = 0; ai < 2; ++ai)
#pragma unroll
            for (int m = 0; m < 4; ++m) { const int row = row0 + ai * HALF + m * 16;
                if (u.pn < 4) { bf16_t* rowp = (u.pn < 2 ? cq : ckv) + (size_t)row * 512 + (u.pn & 1) * BM + colw; float sq = 0.f;
#pragma unroll
                    for (int bj = 0; bj < 2; ++bj) { const f32x4 v0 = acc[ai][bj][m][0], v1 = acc[ai][bj][m][1];
                        u32x4 w; w.x = cvt_pk_bf16(v0[0], v0[1]); w.y = cvt_pk_bf16(v0[2], v0[3]); w.z = cvt_pk_bf16(v1[0], v1[1]); w.w = cvt_pk_bf16(v1[2], v1[3]);
                        *(u32x4*)(rowp + bj * HALF) = w;
                        sq += ((v0[0] * v0[0] + v0[1] * v0[1]) + (v0[2] * v0[2] + v0[3] * v0[3])) + ((v1[0] * v1[0] + v1[1] * v1[1]) + (v1[2] * v1[2] + v1[3] * v1[3])); }
                    sq += __shfl_xor(sq, 16); sq += __shfl_xor(sq, 32);
                    if (fq == 0) ssa[(size_t)row * 16 + u.pn * 4 + wc] = sq; }
                else if (wc < 2) { float* rowp = kpe + (size_t)row * 64 + colw; *(f32x4*)rowp = acc[ai][0][m][0]; *(f32x4*)(rowp + 4) = acc[ai][0][m][1]; } }
    }
};
template <class Epi, class Sched, bool ALIGN_EPI = false, bool SP2 = false>
__device__ __forceinline__ void gemm_phase(PG8_LAS unsigned char* lds, const Gemm g, const Sched& S, const Epi& E) {
    const int tid = threadIdx.x, wid = __builtin_amdgcn_readfirstlane(tid >> 6), lane = tid & 63, wr = wid >> 2, wc = wid & 3, fr = lane & 15, fq = lane >> 4;
    const int K = g.K, nt = K / BK;
    unsigned voffA[2], voffB[2];
#pragma unroll
    for (int i = 0; i < 2; ++i) { int R, C; stage_rc(tid * 16 + i * 8192, R, C); const int Rb = Epi::PERM ? ((R & ~31) + perm32(R & 31)) : R;
        voffA[i] = (unsigned)(R * K + C) * 2u; voffB[i] = (unsigned)(Rb * K + C) * 2u; }
    const size_t kstep = (size_t)(BK * 2);
    const size_t hstep = (size_t)HALF * K * 2;
    const size_t tstep = 2 * hstep;
    const unsigned ldsw = (unsigned)wid * 1024u;
    const int aoff = lds_byte(wr * 64 + fr, fq * 8), boff = lds_byte(wc * 32 + fr, fq * 8);
#define PG8_SA(b, h) (((b) * 2 + (h)) * HTB)
#define PG8_SB(b, h) ((4 + (b) * 2 + (h)) * HTB)
#define PG8_STAGE(bufoff, gbase, voff) do { _Pragma("unroll") for (int _i = 0; _i < 2; ++_i) \
        __builtin_amdgcn_global_load_lds((const unsigned*)((const char*)(gbase) + (voff)[_i]), (PG8_LAS unsigned*)(lds + (bufoff) + ldsw + _i * 8192), 16, 0, 0); } while (0)
#define PG8_LDA(dst, b, h) do { _Pragma("unroll") for (int m = 0; m < 4; ++m) _Pragma("unroll") for (int k = 0; k < 2; ++k) dst[m][k] = *(const PG8_LAS bf16x8*)(lds + PG8_SA(b, h) + aoff + m * 2048 + k * 1024); } while (0)
#define PG8_LDB(dst, b, h) do { _Pragma("unroll") for (int n = 0; n < 2; ++n) _Pragma("unroll") for (int k = 0; k < 2; ++k) dst[n][k] = *(const PG8_LAS bf16x8*)(lds + PG8_SB(b, h) + boff + n * 2048 + k * 1024); } while (0)
#define PG8_MMA(ai, bj, At, Bt) do { __builtin_amdgcn_s_setprio(1); _Pragma("unroll") for (int m = 0; m < 4; ++m) _Pragma("unroll") for (int n = 0; n < 2; ++n) _Pragma("unroll") for (int k = 0; k < 2; ++k) \
        acc[ai][bj][m][n] = __builtin_amdgcn_mfma_f32_16x16x32_bf16(Bt[n][k], At[m][k], acc[ai][bj][m][n], 0, 0, 0); __builtin_amdgcn_s_setprio(0); } while (0)
#define PG8_WAIT_V(n) asm volatile("s_waitcnt vmcnt(" #n ")" ::: "memory")
#define PG8_WAIT_L(n) asm volatile("s_waitcnt lgkmcnt(" #n ")" ::: "memory")
#define PG8_BAR __builtin_amdgcn_s_barrier()
#define PG8_SCHED __builtin_amdgcn_sched_barrier(0)
    Unit cur, nxt; int ui = 0;
    if (!S.next(0, cur)) return;
    f32x4 acc[2][2][4][2];
#pragma unroll
    for (int a = 0; a < 2; ++a)
#pragma unroll
        for (int b = 0; b < 2; ++b)
#pragma unroll
            for (int m = 0; m < 4; ++m)
#pragma unroll
                for (int n = 0; n < 2; ++n) acc[a][b][m][n] = (f32x4){0.f, 0.f, 0.f, 0.f};
    bf16x8 At[4][2], B0[2][2], B1[2][2];
    const char* cA = (const char*)g.A + (size_t)cur.pm * tstep; const char* cB = (const char*)g.Bt + (size_t)cur.pn * tstep;
    S.a_ready(cur);
    if constexpr (SP2) {
        PG8_STAGE(PG8_SB(0, 0), cB, voffB); PG8_STAGE(PG8_SB(0, 1), cB + hstep, voffB); PG8_STAGE(PG8_SA(0, 0), cA, voffA); PG8_STAGE(PG8_SA(0, 1), cA + hstep, voffA);
        if (wr == 1) PG8_BAR;
        PG8_WAIT_V(2); PG8_BAR;
        PG8_STAGE(PG8_SB(1, 0), cB + kstep, voffB); PG8_STAGE(PG8_SA(1, 0), cA + kstep, voffA); PG8_STAGE(PG8_SB(1, 1), cB + hstep + kstep, voffB);
        PG8_WAIT_V(6); PG8_BAR;
    } else {
        PG8_STAGE(PG8_SB(0, 0), cB, voffB); PG8_STAGE(PG8_SA(0, 0), cA, voffA); PG8_STAGE(PG8_SB(0, 1), cB + hstep, voffB); PG8_STAGE(PG8_SA(0, 1), cA + hstep, voffA);
        if (wr == 1) PG8_BAR;
        PG8_WAIT_V(4); PG8_BAR;
        PG8_STAGE(PG8_SB(1, 0), cB + kstep, voffB); PG8_STAGE(PG8_SA(1, 0), cA + kstep, voffA); PG8_STAGE(PG8_SB(1, 1), cB + hstep + kstep, voffB);
        PG8_WAIT_V(6); PG8_BAR;
    }
    for (;;) {
        const bool has_next = S.next(ui + 1, nxt);
        const char* nA = has_next ? (const char*)g.A + (size_t)nxt.pm * tstep : cA; const char* nB = has_next ? (const char*)g.Bt + (size_t)nxt.pn * tstep : cB;
        for (int t = 0; t < nt; t += 2) {
            const bool last = (t == nt - 2);
            const char* a1 = cA + (size_t)(t + 1) * kstep;
            const char* a2 = last ? nA : cA + (size_t)(t + 2) * kstep; const char* b2 = last ? nB : cB + (size_t)(t + 2) * kstep;
            const char* a3 = a2 + kstep; const char* b3 = b2 + kstep;
            if (last && has_next) S.a_ready(nxt);
            if constexpr (SP2) {
            PG8_LDB(B0, 0, 0); PG8_LDB(B1, 0, 1); PG8_SCHED; PG8_LDA(At, 0, 0); PG8_STAGE(PG8_SA(1, 1), a1 + hstep, voffA);
            PG8_WAIT_V(8); PG8_WAIT_L(0); PG8_BAR; PG8_MMA(0, 0, At, B0); PG8_MMA(0, 1, At, B1); PG8_BAR; PG8_SCHED;
            PG8_LDA(At, 0, 1); PG8_STAGE(PG8_SB(0, 0), b2, voffB); PG8_STAGE(PG8_SB(0, 1), b2 + hstep, voffB); PG8_STAGE(PG8_SA(0, 0), a2, voffA);
            PG8_WAIT_V(8); PG8_WAIT_L(0); PG8_BAR; PG8_MMA(1, 0, At, B0); PG8_MMA(1, 1, At, B1); PG8_BAR; PG8_SCHED;
            PG8_LDB(B0, 1, 0); PG8_LDB(B1, 1, 1); PG8_SCHED; PG8_LDA(At, 1, 0); PG8_STAGE(PG8_SA(0, 1), a2 + hstep, voffA);
            PG8_WAIT_V(8); PG8_WAIT_L(0); PG8_BAR; PG8_MMA(0, 0, At, B0); PG8_MMA(0, 1, At, B1); PG8_BAR; PG8_SCHED;
            PG8_LDA(At, 1, 1); PG8_STAGE(PG8_SB(1, 0), b3, voffB); PG8_STAGE(PG8_SB(1, 1), b3 + hstep, voffB); PG8_STAGE(PG8_SA(1, 0), a3, voffA);
            PG8_WAIT_V(8); PG8_WAIT_L(0); PG8_BAR; PG8_MMA(1, 0, At, B0); PG8_MMA(1, 1, At, B1); PG8_BAR; PG8_SCHED;
            } else {
            PG8_LDB(B0, 0, 0); PG8_SCHED; PG8_LDA(At, 0, 0); PG8_STAGE(PG8_SA(1, 1), a1 + hstep, voffA);
            PG8_WAIT_L(8); PG8_BAR; PG8_WAIT_L(0); PG8_MMA(0, 0, At, B0); PG8_BAR; PG8_SCHED;
            PG8_LDB(B1, 0, 1); PG8_STAGE(PG8_SB(0, 0), b2, voffB);
            PG8_BAR; PG8_WAIT_L(0); PG8_MMA(0, 1, At, B1); PG8_BAR;
            PG8_LDA(At, 0, 1); PG8_STAGE(PG8_SA(0, 0), a2, voffA);
            PG8_BAR; PG8_WAIT_L(0); PG8_MMA(1, 0, At, B0); PG8_BAR; PG8_SCHED;
            PG8_STAGE(PG8_SB(0, 1), b2 + hstep, voffB);
            PG8_WAIT_V(6); PG8_BAR; PG8_MMA(1, 1, At, B1); PG8_BAR;
            PG8_LDB(B0, 1, 0); PG8_SCHED; PG8_LDA(At, 1, 0); PG8_STAGE(PG8_SA(0, 1), a2 + hstep, voffA);
            PG8_WAIT_L(8); PG8_BAR; PG8_WAIT_L(0); PG8_MMA(0, 0, At, B0); PG8_BAR; PG8_SCHED;
            PG8_LDB(B1, 1, 1); PG8_STAGE(PG8_SB(1, 0), b3, voffB);
            PG8_BAR; PG8_WAIT_L(0); PG8_MMA(0, 1, At, B1); PG8_BAR;
            PG8_LDA(At, 1, 1); PG8_STAGE(PG8_SA(1, 0), a3, voffA);
            PG8_BAR; PG8_WAIT_L(0); PG8_MMA(1, 0, At, B0); PG8_BAR; PG8_SCHED;
            PG8_STAGE(PG8_SB(1, 1), b3 + hstep, voffB);
            PG8_WAIT_V(6); PG8_BAR; PG8_MMA(1, 1, At, B1); PG8_BAR;
            }
        }
        if constexpr (ALIGN_EPI) { if (wr == 0) PG8_BAR; }
        if constexpr (!Epi::AFTER_DRAIN) { E(acc, cur, wr, wc, fr, fq); S.done(cur); }
        if (!has_next) break;
#pragma unroll
        for (int a = 0; a < 2; ++a)
#pragma unroll
            for (int b = 0; b < 2; ++b)
#pragma unroll
                for (int m = 0; m < 4; ++m)
#pragma unroll
                    for (int n = 0; n < 2; ++n) acc[a][b][m][n] = (f32x4){0.f, 0.f, 0.f, 0.f};
        cur = nxt; cA = nA; cB = nB; ++ui;
        if constexpr (ALIGN_EPI) { if (wr == 1) PG8_BAR; }
    }
    PG8_WAIT_V(0);
    if constexpr (!ALIGN_EPI) { if (wr == 0) PG8_BAR; }
    PG8_BAR;
    if constexpr (Epi::AFTER_DRAIN) { E.fused(acc, cur, wr, wc, fr, fq, lds, wid, lane); S.done(cur); }
#undef PG8_SA
#undef PG8_SB
#undef PG8_STAGE
#undef PG8_LDA
#undef PG8_LDB
#undef PG8_MMA
#undef PG8_WAIT_V
#undef PG8_WAIT_L
#undef PG8_BAR
#undef PG8_SCHED
}
}
namespace att {
#define ATT_LAS __attribute__((address_space(3)))
typedef unsigned short bf16_t;
using bf16x8 = __attribute__((ext_vector_type(8))) short;
using s16x4  = __attribute__((ext_vector_type(4))) short;
using f32x16 = __attribute__((ext_vector_type(16))) float;
using f32x4  = __attribute__((ext_vector_type(4))) float;
using u32x4  = __attribute__((ext_vector_type(4))) unsigned;
#define ATT_SBAR() __builtin_amdgcn_sched_barrier(0)
#ifndef ATT_PRIO
#define ATT_PRIO 0
#endif
#ifndef SM_PK
#define SM_PK 0
#endif
constexpr float THR2 = 8.0f;
constexpr float LOG2E = 1.4426950408889634f;
__device__ __forceinline__ int crow(int r, int hi) { return (r & 3) + 8 * (r >> 2) + 4 * hi; }
__device__ __forceinline__ unsigned cvtpk(float lo, float hi) { unsigned r; asm volatile("v_cvt_pk_bf16_f32 %0, %1, %2" : "=v"(r) : "v"(lo), "v"(hi)); return r; }
__device__ __forceinline__ float bf2f(short x) { return __uint_as_float(((unsigned)(unsigned short)x) << 16); }
__device__ __forceinline__ void glds16(const void* gsrc, unsigned lds_dst) { unsigned keep;
  asm volatile("s_mov_b32 %0, m0\n\ts_mov_b32 m0, %2\n\ts_nop 0\n\tglobal_load_lds_dwordx4 %1, off\n\ts_mov_b32 m0, %0" : "=&s"(keep) : "v"(gsrc), "s"(lds_dst) : "memory"); }
#define ATT_WAIT_BAR() asm volatile("s_waitcnt vmcnt(0) lgkmcnt(0)\n\ts_barrier" ::: "memory")

__device__ __forceinline__ void partialSM2(f32x16& p0, f32x16& p1, float& m_reg, float& alpha) {
  float pmax = p0[0];
#pragma unroll
  for (int r = 1; r < 16; ++r) pmax = fmaxf(pmax, p0[r]);
#pragma unroll
  for (int r = 0; r < 16; ++r) pmax = fmaxf(pmax, p1[r]);
  { auto rr = __builtin_amdgcn_permlane32_swap(__float_as_uint(pmax), __float_as_uint(pmax), false, false);
    pmax = fmaxf(__uint_as_float(rr[0]), __uint_as_float(rr[1])); }
  if (__builtin_expect(__all(pmax - m_reg <= THR2), 1)) { alpha = 1.f; }
  else { const float mn = fmaxf(m_reg, pmax); alpha = __builtin_amdgcn_exp2f(m_reg - mn); m_reg = mn; }
#if SM_PK
  { typedef float f32x2_ __attribute__((ext_vector_type(2))); f32x2_ nm = {-m_reg, -m_reg}; asm volatile("" : "+v"(nm));
#pragma unroll
    for (int r = 0; r < 16; r += 2) { f32x2_ a = {p0[r], p0[r + 1]}, b = {p1[r], p1[r + 1]}; a += nm; b += nm; p0[r] = a[0]; p0[r + 1] = a[1]; p1[r] = b[0]; p1[r + 1] = b[1]; } }
#else
#pragma unroll
  for (int r = 0; r < 16; ++r) { p0[r] -= m_reg; p1[r] -= m_reg; }
#endif
#pragma unroll
  for (int r = 0; r < 16; ++r) p0[r] = __builtin_amdgcn_exp2f(p0[r]);
}
__device__ __forceinline__ void partialSM2n(f32x16& p0, f32x16& p1, f32x16& negm, float& alpha) {
  float pmax = p0[0];
#pragma unroll
  for (int r = 1; r < 16; ++r) pmax = fmaxf(pmax, p0[r]);
#pragma unroll
  for (int r = 0; r < 16; ++r) pmax = fmaxf(pmax, p1[r]);
  { auto rr = __builtin_amdgcn_permlane32_swap(__float_as_uint(pmax), __float_as_uint(pmax), false, false);
    pmax = fmaxf(__uint_as_float(rr[0]), __uint_as_float(rr[1])); }
  if (__builtin_expect(__all(pmax <= THR2), 1)) { alpha = 1.f; }
  else { const float d = fmaxf(pmax, 0.f); alpha = __builtin_amdgcn_exp2f(-d); const float nm = negm[0] - d;
#pragma unroll
    for (int r = 0; r < 16; ++r) { p0[r] -= d; p1[r] -= d; negm[r] = nm; } }
#pragma unroll
  for (int r = 0; r < 16; ++r) p0[r] = __builtin_amdgcn_exp2f(p0[r]);
}
__device__ __forceinline__ void finishSM(f32x16& p0, f32x16& p1, float alpha, float& l_reg, bf16x8& pa0, bf16x8& pa1, bf16x8& pa2, bf16x8& pa3) {
#pragma unroll
  for (int r = 0; r < 16; ++r) p1[r] = __builtin_amdgcn_exp2f(p1[r]);
#if SM_PK
  float ps;
  { typedef float f32x2_ __attribute__((ext_vector_type(2))); f32x2_ a = {p0[0], p0[1]}, b = {p1[0], p1[1]};
#pragma unroll
    for (int r = 2; r < 16; r += 2) { a += (f32x2_){p0[r], p0[r + 1]}; b += (f32x2_){p1[r], p1[r + 1]}; }
    a += b; ps = a[0] + a[1]; }
#else
  float ps = 0;
#pragma unroll
  for (int r = 0; r < 16; ++r) ps += p0[r];
#pragma unroll
  for (int r = 0; r < 16; ++r) ps += p1[r];
#endif
  { auto rr = __builtin_amdgcn_permlane32_swap(__float_as_uint(ps), __float_as_uint(ps), false, false);
    ps = __uint_as_float(rr[0]) + __uint_as_float(rr[1]); }
  l_reg = l_reg * alpha + ps;
#define ATT_PK4(P, BASE, OUT) do { unsigned a0 = cvtpk(P[BASE + 0], P[BASE + 1]), a1 = cvtpk(P[BASE + 2], P[BASE + 3]);   \
    unsigned b0 = cvtpk(P[BASE + 4], P[BASE + 5]), b1 = cvtpk(P[BASE + 6], P[BASE + 7]);                              \
    auto r0 = __builtin_amdgcn_permlane32_swap(a0, b0, false, false); auto r1 = __builtin_amdgcn_permlane32_swap(a1, b1, false, false); \
    u32x4 w = {r0[0], r1[0], r0[1], r1[1]}; OUT = *reinterpret_cast<bf16x8*>(&w); } while (0)
  ATT_PK4(p0, 0, pa0); ATT_PK4(p0, 8, pa1); ATT_PK4(p1, 0, pa2); ATT_PK4(p1, 8, pa3);
#undef ATT_PK4
}
__device__ __forceinline__ int v_rd_base(int lane) { return ((lane & 3) << 3) | (((lane >> 2) & 3) << 6) | (((lane >> 4) & 1) << 5) | (((lane >> 5) & 1) << 8); }
template <int OFF> __device__ __forceinline__ s16x4 tr_read(int vb) {
  s16x4 r; asm volatile("ds_read_b64_tr_b16 %0, %1 offset:%2" : "=&v"(r) : "v"(vb), "i"(OFF) : "memory"); return r;
}
template <int NCB, int D0> __device__ __forceinline__ void pv_one(f32x16& od, int vb, bf16x8 pa0, bf16x8 pa1, bf16x8 pa2, bf16x8 pa3) {
  constexpr int KS = 1024 * NCB, HF = 512 * NCB;
  const s16x4 l0 = tr_read<D0 * 512 + 0 * KS>(vb), h0 = tr_read<D0 * 512 + 0 * KS + HF>(vb), l1 = tr_read<D0 * 512 + 1 * KS>(vb), h1 = tr_read<D0 * 512 + 1 * KS + HF>(vb);
  const s16x4 l2 = tr_read<D0 * 512 + 2 * KS>(vb), h2 = tr_read<D0 * 512 + 2 * KS + HF>(vb), l3 = tr_read<D0 * 512 + 3 * KS>(vb), h3 = tr_read<D0 * 512 + 3 * KS + HF>(vb);
  asm volatile("s_waitcnt lgkmcnt(0)" ::: "memory"); ATT_SBAR();
#define ATT_PK(L, H) (bf16x8){L[0], L[1], L[2], L[3], H[0], H[1], H[2], H[3]}
  od = __builtin_amdgcn_mfma_f32_32x32x16_bf16(pa0, ATT_PK(l0, h0), od, 0, 0, 0);
  od = __builtin_amdgcn_mfma_f32_32x32x16_bf16(pa1, ATT_PK(l1, h1), od, 0, 0, 0);
  od = __builtin_amdgcn_mfma_f32_32x32x16_bf16(pa2, ATT_PK(l2, h2), od, 0, 0, 0);
  od = __builtin_amdgcn_mfma_f32_32x32x16_bf16(pa3, ATT_PK(l3, h3), od, 0, 0, 0);
#undef ATT_PK
}
#define ATT_RESC(ND, a) do { if (__any((a) < 1.f)) { if (hi == 0) al_l[r32] = (a); asm volatile("s_waitcnt lgkmcnt(0)" ::: "memory"); \
    _Pragma("unroll") for (int d_ = 0; d_ < ND; ++d_) _Pragma("unroll") for (int r_ = 0; r_ < 16; ++r_) o[d_][r_] *= al_l[crow(r_, hi)]; } } while (0)

namespace mla {
constexpr int S = 8192, LDQ = 3072, LDK = 3072, LDV = 4096, LDO = 2048, NT = S / 64;
constexpr int KP = 400, KT = 64 * KP, VT = 16384, K_OFF0 = 0, K_OFF1 = KT, V_OFF0 = 2 * KT, V_OFF1 = 2 * KT + VT, LDS_END = 2 * KT + 2 * VT;
constexpr int OST_PITCH = 136;
static_assert(8 * 32 * OST_PITCH * 2 <= LDS_END, "O staging fits in the K/V region");
__device__ __forceinline__ void qkt(f32x16& p0, f32x16& p1, const ATT_LAS unsigned char* Ks, const bf16x8* qr, int r32, int hi) {
  p0 = f32x16{}; p1 = f32x16{};
  const ATT_LAS unsigned char* kb = Ks + r32 * KP + hi * 16;
#pragma unroll
  for (int d0 = 0; d0 < 12; ++d0) {
    const bf16x8 b0 = *reinterpret_cast<const ATT_LAS bf16x8*>(kb + d0 * 32);
    const bf16x8 b1 = *reinterpret_cast<const ATT_LAS bf16x8*>(kb + 32 * KP + d0 * 32);
    p0 = __builtin_amdgcn_mfma_f32_32x32x16_bf16(b0, qr[d0], p0, 0, 0, 0);
    p1 = __builtin_amdgcn_mfma_f32_32x32x16_bf16(b1, qr[d0], p1, 0, 0, 0); }
}
__device__ __forceinline__ void pv4(f32x16* o, int vb, bf16x8 pa0, bf16x8 pa1, bf16x8 pa2, bf16x8 pa3) {
  pv_one<4, 0>(o[0], vb, pa0, pa1, pa2, pa3); pv_one<4, 1>(o[1], vb, pa0, pa1, pa2, pa3); pv_one<4, 2>(o[2], vb, pa0, pa1, pa2, pa3); pv_one<4, 3>(o[3], vb, pa0, pa1, pa2, pa3);
}
typedef short v4i16_t __attribute__((ext_vector_type(4)));
__device__ __forceinline__ s16x4 vtr(const ATT_LAS unsigned char* p) { return __builtin_bit_cast(s16x4, __builtin_amdgcn_ds_read_tr16_b64_v4i16((ATT_LAS v4i16_t*)p)); }
template <bool PV> __device__ __forceinline__ void mfma_block(f32x16& p0, f32x16& p1, f32x16* o, const ATT_LAS unsigned char* Ks, const ATT_LAS unsigned char* Vp, const bf16x8* qr, const bf16x8* pa, int r32, int hi) {
  const ATT_LAS unsigned char* kb = Ks + r32 * KP + hi * 16;
  bf16x8 k0[3], k1[3]; s16x4 vl[6], vh[6];
#define MB_KLD(s) do { k0[(s) % 3] = *reinterpret_cast<const ATT_LAS bf16x8*>(kb + (s) * 32); k1[(s) % 3] = *reinterpret_cast<const ATT_LAS bf16x8*>(kb + 32 * KP + (s) * 32); } while (0)
#define MB_VLD(s) do { vl[(s) % 6] = vtr(Vp + ((s) >> 2) * 512 + ((s) & 3) * 4096); vh[(s) % 6] = vtr(Vp + ((s) >> 2) * 512 + ((s) & 3) * 4096 + 2048); } while (0)
  MB_KLD(0); MB_KLD(1);
  p0 = f32x16{}; p1 = f32x16{};
#pragma unroll
  for (int d0 = 0; d0 < 12; ++d0) {
    if (d0 + 2 < 12) MB_KLD(d0 + 2);
    if (PV && d0 >= 7) MB_VLD(d0 - 7);
    ATT_SBAR();
    p0 = __builtin_amdgcn_mfma_f32_32x32x16_bf16(k0[d0 % 3], qr[d0], p0, 0, 0, 0);
    p1 = __builtin_amdgcn_mfma_f32_32x32x16_bf16(k1[d0 % 3], qr[d0], p1, 0, 0, 0);
    ATT_SBAR();
  }
  if (PV) {
#pragma unroll
    for (int s = 0; s < 16; ++s) {
      if (s + 5 < 16) MB_VLD(s + 5);
      ATT_SBAR();
      const s16x4 L = vl[s % 6], H = vh[s % 6];
      o[s >> 2] = __builtin_amdgcn_mfma_f32_32x32x16_bf16(pa[s & 3], (bf16x8){L[0], L[1], L[2], L[3], H[0], H[1], H[2], H[3]}, o[s >> 2], 0, 0, 0);
      ATT_SBAR();
    }
  }
#undef MB_KLD
#undef MB_VLD
}
template <bool PV> __device__ __forceinline__ void mfma_block_n(f32x16& p0, f32x16& p1, f32x16* o, const ATT_LAS unsigned char* Ks, const ATT_LAS unsigned char* Vp, const bf16x8* qr, const bf16x8* pa, int r32, int hi, const f32x16& cinit) {
  const ATT_LAS unsigned char* kb = Ks + r32 * KP + hi * 16;
  bf16x8 k0[3], k1[3]; s16x4 vl[6], vh[6];
#define MB_KLD(s) do { k0[(s) % 3] = *reinterpret_cast<const ATT_LAS bf16x8*>(kb + (s) * 32); k1[(s) % 3] = *reinterpret_cast<const ATT_LAS bf16x8*>(kb + 32 * KP + (s) * 32); } while (0)
#define MB_VLD(s) do { vl[(s) % 6] = vtr(Vp + ((s) >> 2) * 512 + ((s) & 3) * 4096); vh[(s) % 6] = vtr(Vp + ((s) >> 2) * 512 + ((s) & 3) * 4096 + 2048); } while (0)
  MB_KLD(0); MB_KLD(1);
#pragma unroll
  for (int d0 = 0; d0 < 12; ++d0) {
    if (d0 + 2 < 12) MB_KLD(d0 + 2);
    if (PV && d0 >= 7) MB_VLD(d0 - 7);
    ATT_SBAR();
    p0 = __builtin_amdgcn_mfma_f32_32x32x16_bf16(k0[d0 % 3], qr[d0], d0 == 0 ? cinit : p0, 0, 0, 0);
    p1 = __builtin_amdgcn_mfma_f32_32x32x16_bf16(k1[d0 % 3], qr[d0], d0 == 0 ? cinit : p1, 0, 0, 0);
    ATT_SBAR();
  }
  if (PV) {
#pragma unroll
    for (int s = 0; s < 16; ++s) {
      if (s + 5 < 16) MB_VLD(s + 5);
      ATT_SBAR();
      const s16x4 L = vl[s % 6], H = vh[s % 6];
      o[s >> 2] = __builtin_amdgcn_mfma_f32_32x32x16_bf16(pa[s & 3], (bf16x8){L[0], L[1], L[2], L[3], H[0], H[1], H[2], H[3]}, o[s >> 2], 0, 0, 0);
      ATT_SBAR();
    }
  }
#undef MB_KLD
#undef MB_VLD
}
#define ATT_BAR() asm volatile("s_barrier" ::: "memory")
template <int MODE> __device__ __forceinline__ void unit_stag(ATT_LAS unsigned char* lds, ATT_LAS float* wscr, const bf16_t* __restrict__ Qn, const bf16_t* __restrict__ Kn, const bf16_t* __restrict__ KV, bf16_t* __restrict__ O, int h, int qb,
                                                                const float* __restrict__ qg, const float* __restrict__ COS, const float* __restrict__ SIN) {
  const int tid = threadIdx.x, lane = tid & 63, r32 = lane & 31, hi = lane >> 5; const int wid = __builtin_amdgcn_readfirstlane(tid >> 6); const int half = wid >> 2;
  const unsigned lds0 = (unsigned)(uintptr_t)lds;
  ATT_LAS float* al_l = wscr + wid * 64; ATT_LAS float* li_l = al_l + 32;
  const bf16_t* Kh = Kn + h * 192; const bf16_t* Vh = KV + h * 256 + 128;
  int koff[4], voff[2];
#pragma unroll
  for (int i = 0; i < 4; ++i) { const int p = (wid + 8 * i) * 64 + lane, row = p / 25, c = p % 25; koff[i] = row * LDK + (c < 24 ? c : 23) * 8; }
#pragma unroll
  for (int i = 0; i < 2; ++i) { const int B = (wid + 8 * i) * 1024 + lane * 16, st = B >> 9, wi = B & 511, kk = (st >> 2) * 8 + (wi >> 6), c = (st & 3) * 32 + ((wi & 63) >> 1);
    const int k = (kk & ~0xC) | ((kk & 4) << 1) | ((kk & 8) >> 1); voff[i] = k * LDV + c; }
#define MLA_DMA_K(t, buf) do { if ((MODE & 2) && (t) > 1) break; const bf16_t* kt_ = Kh + (size_t)(t) * 64 * LDK; const unsigned b_ = lds0 + (unsigned)(buf); \
    glds16(kt_ + koff[0], b_ + (unsigned)wid * 1024u); glds16(kt_ + koff[1], b_ + (unsigned)(wid + 8) * 1024u); glds16(kt_ + koff[2], b_ + (unsigned)(wid + 16) * 1024u); \
    if (wid == 0) glds16(kt_ + koff[3], b_ + 24u * 1024u); } while (0)
#define MLA_DMA_V(t, buf) do { if ((MODE & 2) && (t) > 1) break; const bf16_t* vt_ = Vh + (size_t)(t) * 64 * LDV; const unsigned b_ = lds0 + (unsigned)(buf); \
    glds16(vt_ + voff[0], b_ + (unsigned)wid * 1024u); glds16(vt_ + voff[1], b_ + (unsigned)(wid + 8) * 1024u); } while (0)
  MLA_DMA_K(0, K_OFF0);
  bf16x8 qr[12];
  { const int tok = qb * 256 + wid * 32 + r32; const bf16_t* Qw = Qn + (size_t)tok * LDQ + h * 192 + hi * 8; float ss = 0.f;
#pragma unroll
    for (int d0 = 0; d0 < 12; ++d0) { qr[d0] = *reinterpret_cast<const bf16x8*>(Qw + d0 * 16);
#pragma unroll
      for (int e = 0; e < 8; ++e) { const float f = bf2f(qr[d0][e]); ss += f * f; } }
    { auto rr = __builtin_amdgcn_permlane32_swap(__float_as_uint(ss), __float_as_uint(ss), false, false); ss = __uint_as_float(rr[0]) + __uint_as_float(rr[1]); }
    const float rq = (LOG2E * 0.07216878364870322f) / sqrtf(ss * (1.0f / 192.0f) + 1e-6f);
#pragma unroll
    for (int d0 = 0; d0 < 8; ++d0) { const f32x4 ga = *(const f32x4*)(qg + d0 * 16 + hi * 8), gb = *(const f32x4*)(qg + d0 * 16 + hi * 8 + 4);
      u32x4 w; w.x = cvtpk(bf2f(qr[d0][0]) * rq * ga[0], bf2f(qr[d0][1]) * rq * ga[1]); w.y = cvtpk(bf2f(qr[d0][2]) * rq * ga[2], bf2f(qr[d0][3]) * rq * ga[3]);
      w.z = cvtpk(bf2f(qr[d0][4]) * rq * gb[0], bf2f(qr[d0][5]) * rq * gb[1]); w.w = cvtpk(bf2f(qr[d0][6]) * rq * gb[2], bf2f(qr[d0][7]) * rq * gb[3]);
      qr[d0] = *reinterpret_cast<bf16x8*>(&w); }
#pragma unroll
    for (int d0 = 8; d0 < 10; ++d0) { const int jj = (d0 - 8) * 16 + hi * 8;
      const f32x4 gxa = *(const f32x4*)(qg + 128 + jj), gxb = *(const f32x4*)(qg + 128 + jj + 4), gya = *(const f32x4*)(qg + 160 + jj), gyb = *(const f32x4*)(qg + 160 + jj + 4);
      const f32x4 ca = *(const f32x4*)(COS + (size_t)tok * 32 + jj), cb = *(const f32x4*)(COS + (size_t)tok * 32 + jj + 4), sa = *(const f32x4*)(SIN + (size_t)tok * 32 + jj), sb = *(const f32x4*)(SIN + (size_t)tok * 32 + jj + 4);
      float xo[8], yo[8];
#pragma unroll
      for (int e = 0; e < 8; ++e) { const float gx = e < 4 ? gxa[e] : gxb[e - 4], gy = e < 4 ? gya[e] : gyb[e - 4], c = e < 4 ? ca[e] : cb[e - 4], s = e < 4 ? sa[e] : sb[e - 4];
        const float x = bf2f(qr[d0][e]) * rq * gx, y = bf2f(qr[d0 + 2][e]) * rq * gy; xo[e] = x * c - y * s; yo[e] = y * c + x * s; }
      u32x4 wx = {cvtpk(xo[0], xo[1]), cvtpk(xo[2], xo[3]), cvtpk(xo[4], xo[5]), cvtpk(xo[6], xo[7])}, wy = {cvtpk(yo[0], yo[1]), cvtpk(yo[2], yo[3]), cvtpk(yo[4], yo[5]), cvtpk(yo[6], yo[7])};
      qr[d0] = *reinterpret_cast<bf16x8*>(&wx); qr[d0 + 2] = *reinterpret_cast<bf16x8*>(&wy); }
  }
  float m_reg = -1e30f, l_reg = 0.f; f32x16 o[4] = {};
  f32x16 p0, p1; float al = 1.f; bf16x8 pa[4] = {};
  const int vbase = (int)(lds0 + V_OFF0) + v_rd_base(lane); const ATT_LAS unsigned char* vptr = lds + V_OFF0 + v_rd_base(lane);
  ATT_WAIT_BAR();
  if (half) { MLA_DMA_K(1, K_OFF1); MLA_DMA_V(0, V_OFF0); ATT_BAR(); }
  if (!half) { MLA_DMA_K(1, K_OFF1); MLA_DMA_V(0, V_OFF0); }
  __builtin_amdgcn_s_setprio(1);
  mfma_block<false>(p0, p1, o, lds + K_OFF0, vptr, qr, pa, r32, hi);
  __builtin_amdgcn_s_setprio(0);
  if (half) ATT_WAIT_BAR(); else ATT_BAR();
  if (half) { MLA_DMA_K(2, K_OFF0); MLA_DMA_V(1, V_OFF1); }
  partialSM2(p0, p1, m_reg, al);
  finishSM(p0, p1, al, l_reg, pa[0], pa[1], pa[2], pa[3]);
  if (half) ATT_BAR(); else ATT_WAIT_BAR();
#pragma unroll 1
  for (int j = 1; j < NT; ++j) {
    const int kb = (j & 1) * KT, vprev = ((j + 1) & 1) * VT;
    if (!half) { if (j + 1 < NT) MLA_DMA_K(j + 1, K_OFF0 + (KT - kb)); MLA_DMA_V(j, V_OFF0 + (VT - vprev)); }
    __builtin_amdgcn_s_setprio(1);
    mfma_block<true>(p0, p1, o, lds + K_OFF0 + kb, vptr + vprev, qr, pa, r32, hi);
    __builtin_amdgcn_s_setprio(0);
    if (half) ATT_WAIT_BAR(); else ATT_BAR();
    if (half) { if (j + 2 < NT) MLA_DMA_K(j + 2, K_OFF0 + kb); if (j + 1 < NT) MLA_DMA_V(j + 1, V_OFF0 + vprev); }
    if (!(MODE & 1)) { partialSM2(p0, p1, m_reg, al); ATT_RESC(4, al);
    finishSM(p0, p1, al, l_reg, pa[0], pa[1], pa[2], pa[3]); }
    else { asm volatile("" : "+v"(p0), "+v"(p1)); l_reg += p0[0] + p1[5]; }
    if (half) ATT_BAR(); else ATT_WAIT_BAR();
  }
  pv4(o, vbase + ((NT - 1) & 1) * VT, pa[0], pa[1], pa[2], pa[3]);
  if (!half) ATT_BAR();
  if (hi == 0) li_l[r32] = l_reg;
  ATT_WAIT_BAR();
  float rli[16];
#pragma unroll
  for (int r = 0; r < 16; ++r) rli[r] = __builtin_amdgcn_rcpf(li_l[crow(r, hi)]);
  ATT_LAS bf16_t* stg = (ATT_LAS bf16_t*)lds + wid * (32 * OST_PITCH);
#pragma unroll
  for (int r = 0; r < 16; ++r) { const int orow = crow(r, hi);
#pragma unroll
    for (int d0 = 0; d0 < 4; ++d0) { const unsigned w = cvtpk(o[d0][r] * rli[r], 0.f); stg[orow * OST_PITCH + d0 * 32 + r32] = (bf16_t)(w & 0xffffu); } }
  asm volatile("s_waitcnt lgkmcnt(0)" ::: "memory");
  bf16_t* Ow = O + (size_t)(qb * 256 + wid * 32) * LDO + h * 128;
#pragma unroll
  for (int i = 0; i < 8; ++i) { const int row = i * 4 + (lane >> 4), ch = lane & 15; const u32x4 v = *(const ATT_LAS u32x4*)(stg + row * OST_PITCH + ch * 8); *(u32x4*)(Ow + (size_t)row * LDO + ch * 8) = v; }
  ATT_WAIT_BAR();
#undef MLA_DMA_K
#undef MLA_DMA_V
}
template <int MODE> __device__ __forceinline__ void unit_soft(ATT_LAS unsigned char* lds, ATT_LAS float* wscr, const bf16_t* __restrict__ Qn, const bf16_t* __restrict__ Kn, const bf16_t* __restrict__ KV, bf16_t* __restrict__ O, int h, int qb,
                                                                const float* __restrict__ qg, const float* __restrict__ COS, const float* __restrict__ SIN) {
  const int tid = threadIdx.x, lane = tid & 63, r32 = lane & 31, hi = lane >> 5; const int wid = __builtin_amdgcn_readfirstlane(tid >> 6); const int half = wid >> 2;
  const unsigned lds0 = (unsigned)(uintptr_t)lds;
  ATT_LAS float* al_l = wscr + wid * 64; ATT_LAS float* li_l = al_l + 32;
  const bf16_t* Kh = Kn + h * 192; const bf16_t* Vh = KV + h * 256 + 128;
  int koff[4], voff[2];
#pragma unroll
  for (int i = 0; i < 4; ++i) { const int p = (wid + 8 * i) * 64 + lane, row = p / 25, c = p % 25; koff[i] = row * LDK + (c < 24 ? c : 23) * 8; }
#pragma unroll
  for (int i = 0; i < 2; ++i) { const int B = (wid + 8 * i) * 1024 + lane * 16, st = B >> 9, wi = B & 511, kk = (st >> 2) * 8 + (wi >> 6), c = (st & 3) * 32 + ((wi & 63) >> 1);
    const int k = (kk & ~0xC) | ((kk & 4) << 1) | ((kk & 8) >> 1); voff[i] = k * LDV + c; }
#define MLA_DMA_K(t, buf) do { if ((MODE & 2) && (t) > 1) break; const bf16_t* kt_ = Kh + (size_t)(t) * 64 * LDK; const unsigned b_ = lds0 + (unsigned)(buf); \
    glds16(kt_ + koff[0], b_ + (unsigned)wid * 1024u); glds16(kt_ + koff[1], b_ + (unsigned)(wid + 8) * 1024u); glds16(kt_ + koff[2], b_ + (unsigned)(wid + 16) * 1024u); \
    if (wid == 0) glds16(kt_ + koff[3], b_ + 24u * 1024u); } while (0)
#define MLA_DMA_V(t, buf) do { if ((MODE & 2) && (t) > 1) break; const bf16_t* vt_ = Vh + (size_t)(t) * 64 * LDV; const unsigned b_ = lds0 + (unsigned)(buf); \
    glds16(vt_ + voff[0], b_ + (unsigned)wid * 1024u); glds16(vt_ + voff[1], b_ + (unsigned)(wid + 8) * 1024u); } while (0)
  MLA_DMA_K(0, K_OFF0);
  bf16x8 qr[12];
  { const int tok = qb * 256 + wid * 32 + r32; const bf16_t* Qw = Qn + (size_t)tok * LDQ + h * 192 + hi * 8; float ss = 0.f;
#pragma unroll
    for (int d0 = 0; d0 < 12; ++d0) { qr[d0] = *reinterpret_cast<const bf16x8*>(Qw + d0 * 16);
#pragma unroll
      for (int e = 0; e < 8; ++e) { const float f = bf2f(qr[d0][e]); ss += f * f; } }
    { auto rr = __builtin_amdgcn_permlane32_swap(__float_as_uint(ss), __float_as_uint(ss), false, false); ss = __uint_as_float(rr[0]) + __uint_as_float(rr[1]); }
    const float rq = (LOG2E * 0.07216878364870322f) / sqrtf(ss * (1.0f / 192.0f) + 1e-6f);
#pragma unroll
    for (int d0 = 0; d0 < 8; ++d0) { const f32x4 ga = *(const f32x4*)(qg + d0 * 16 + hi * 8), gb = *(const f32x4*)(qg + d0 * 16 + hi * 8 + 4);
      u32x4 w; w.x = cvtpk(bf2f(qr[d0][0]) * rq * ga[0], bf2f(qr[d0][1]) * rq * ga[1]); w.y = cvtpk(bf2f(qr[d0][2]) * rq * ga[2], bf2f(qr[d0][3]) * rq * ga[3]);
      w.z = cvtpk(bf2f(qr[d0][4]) * rq * gb[0], bf2f(qr[d0][5]) * rq * gb[1]); w.w = cvtpk(bf2f(qr[d0][6]) * rq * gb[2], bf2f(qr[d0][7]) * rq * gb[3]);
      qr[d0] = *reinterpret_cast<bf16x8*>(&w); }
#pragma unroll
    for (int d0 = 8; d0 < 10; ++d0) { const int jj = (d0 - 8) * 16 + hi * 8;
      const f32x4 gxa = *(const f32x4*)(qg + 128 + jj), gxb = *(const f32x4*)(qg + 128 + jj + 4), gya = *(const f32x4*)(qg + 160 + jj), gyb = *(const f32x4*)(qg + 160 + jj + 4);
      const f32x4 ca = *(const f32x4*)(COS + (size_t)tok * 32 + jj), cb = *(const f32x4*)(COS + (size_t)tok * 32 + jj + 4), sa = *(const f32x4*)(SIN + (size_t)tok * 32 + jj), sb = *(const f32x4*)(SIN + (size_t)tok * 32 + jj + 4);
      float xo[8], yo[8];
#pragma unroll
      for (int e = 0; e < 8; ++e) { const float gx = e < 4 ? gxa[e] : gxb[e - 4], gy = e < 4 ? gya[e] : gyb[e - 4], c = e < 4 ? ca[e] : cb[e - 4], s = e < 4 ? sa[e] : sb[e - 4];
        const float x = bf2f(qr[d0][e]) * rq * gx, y = bf2f(qr[d0 + 2][e]) * rq * gy; xo[e] = x * c - y * s; yo[e] = y * c + x * s; }
      u32x4 wx = {cvtpk(xo[0], xo[1]), cvtpk(xo[2], xo[3]), cvtpk(xo[4], xo[5]), cvtpk(xo[6], xo[7])}, wy = {cvtpk(yo[0], yo[1]), cvtpk(yo[2], yo[3]), cvtpk(yo[4], yo[5]), cvtpk(yo[6], yo[7])};
      qr[d0] = *reinterpret_cast<bf16x8*>(&wx); qr[d0 + 2] = *reinterpret_cast<bf16x8*>(&wy); }
  }
  float m_reg = -1e30f, l_reg = 0.f; f32x16 o[4] = {};
  f32x16 p0, p1; float al = 1.f; bf16x8 pa[4] = {};
  const int vbase = (int)(lds0 + V_OFF0) + v_rd_base(lane); const ATT_LAS unsigned char* vptr = lds + V_OFF0 + v_rd_base(lane);
  ATT_WAIT_BAR();
  if (half) { MLA_DMA_K(1, K_OFF1); MLA_DMA_V(0, V_OFF0); ATT_BAR(); }
  if (!half) { MLA_DMA_K(1, K_OFF1); MLA_DMA_V(0, V_OFF0); }
  __builtin_amdgcn_s_setprio(1);
  mfma_block<false>(p0, p1, o, lds + K_OFF0, vptr, qr, pa, r32, hi);
  __builtin_amdgcn_s_setprio(0);
  if (half) ATT_WAIT_BAR(); else ATT_BAR();
  if (half) { MLA_DMA_K(2, K_OFF0); MLA_DMA_V(1, V_OFF1); }
  partialSM2(p0, p1, m_reg, al);
  finishSM(p0, p1, al, l_reg, pa[0], pa[1], pa[2], pa[3]);
  if (!half) ATT_WAIT_BAR();
#pragma unroll 1
  for (int j = 1; j < NT; ++j) {
    const int kb = (j & 1) * KT, vprev = ((j + 1) & 1) * VT;
    if (!half) { if (j + 1 < NT) MLA_DMA_K(j + 1, K_OFF0 + (KT - kb)); MLA_DMA_V(j, V_OFF0 + (VT - vprev)); }
    __builtin_amdgcn_s_setprio(1);
    mfma_block<true>(p0, p1, o, lds + K_OFF0 + kb, vptr + vprev, qr, pa, r32, hi);
    __builtin_amdgcn_s_setprio(0);
    if (half) ATT_WAIT_BAR();
    if (half) { if (j + 2 < NT) MLA_DMA_K(j + 2, K_OFF0 + kb); if (j + 1 < NT) MLA_DMA_V(j + 1, V_OFF0 + vprev); }
    if (!(MODE & 1)) { partialSM2(p0, p1, m_reg, al); ATT_RESC(4, al);
    finishSM(p0, p1, al, l_reg, pa[0], pa[1], pa[2], pa[3]); }
    else { asm volatile("" : "+v"(p0), "+v"(p1)); l_reg += p0[0] + p1[5]; }
    if (!half) ATT_WAIT_BAR();
  }
  pv4(o, vbase + ((NT - 1) & 1) * VT, pa[0], pa[1], pa[2], pa[3]);
  if (hi == 0) li_l[r32] = l_reg;
  ATT_WAIT_BAR();
  float rli[16];
#pragma unroll
  for (int r = 0; r < 16; ++r) rli[r] = __builtin_amdgcn_rcpf(li_l[crow(r, hi)]);
  ATT_LAS bf16_t* stg = (ATT_LAS bf16_t*)lds + wid * (32 * OST_PITCH);
#pragma unroll
  for (int r = 0; r < 16; ++r) { const int orow = crow(r, hi);
#pragma unroll
    for (int d0 = 0; d0 < 4; ++d0) { const unsigned w = cvtpk(o[d0][r] * rli[r], 0.f); stg[orow * OST_PITCH + d0 * 32 + r32] = (bf16_t)(w & 0xffffu); } }
  asm volatile("s_waitcnt lgkmcnt(0)" ::: "memory");
  bf16_t* Ow = O + (size_t)(qb * 256 + wid * 32) * LDO + h * 128;
#pragma unroll
  for (int i = 0; i < 8; ++i) { const int row = i * 4 + (lane >> 4), ch = lane & 15; const u32x4 v = *(const ATT_LAS u32x4*)(stg + row * OST_PITCH + ch * 8); *(u32x4*)(Ow + (size_t)row * LDO + ch * 8) = v; }
  ATT_WAIT_BAR();
#undef MLA_DMA_K
#undef MLA_DMA_V
}
template <int MODE> __device__ __forceinline__ void unit_softn(ATT_LAS unsigned char* lds, ATT_LAS float* wscr, const bf16_t* __restrict__ Qn, const bf16_t* __restrict__ Kn, const bf16_t* __restrict__ KV, bf16_t* __restrict__ O, int h, int qb,
                                                                const float* __restrict__ qg, const float* __restrict__ COS, const float* __restrict__ SIN) {
  int tid = threadIdx.x; asm volatile("" : "+v"(tid));
  const int lane = tid & 63, r32 = lane & 31, hi = lane >> 5; const int wid = __builtin_amdgcn_readfirstlane(tid >> 6); const int half = wid >> 2;
  const unsigned lds0 = (unsigned)(uintptr_t)lds;
  ATT_LAS float* al_l = wscr + wid * 64; ATT_LAS float* li_l = al_l + 32;
  const bf16_t* Kh = Kn + h * 192; const bf16_t* Vh = KV + h * 256 + 128;
  int koff[4], voff[2];
#pragma unroll
  for (int i = 0; i < 4; ++i) { const int p = (wid + 8 * i) * 64 + lane, row = p / 25, c = p % 25; koff[i] = row * LDK + (c < 24 ? c : 23) * 8; }
#pragma unroll
  for (int i = 0; i < 2; ++i) { const int B = (wid + 8 * i) * 1024 + lane * 16, st = B >> 9, wi = B & 511, kk = (st >> 2) * 8 + (wi >> 6), c = (st & 3) * 32 + ((wi & 63) >> 1);
    const int k = (kk & ~0xC) | ((kk & 4) << 1) | ((kk & 8) >> 1); voff[i] = k * LDV + c; }
#define MLA_DMA_K(t, buf) do { if ((MODE & 2) && (t) > 1) break; const bf16_t* kt_ = Kh + (size_t)(t) * 64 * LDK; const unsigned b_ = lds0 + (unsigned)(buf); \
    glds16(kt_ + koff[0], b_ + (unsigned)wid * 1024u); glds16(kt_ + koff[1], b_ + (unsigned)(wid + 8) * 1024u); glds16(kt_ + koff[2], b_ + (unsigned)(wid + 16) * 1024u); \
    if (wid == 0) glds16(kt_ + koff[3], b_ + 24u * 1024u); } while (0)
#define MLA_DMA_V(t, buf) do { if ((MODE & 2) && (t) > 1) break; const bf16_t* vt_ = Vh + (size_t)(t) * 64 * LDV; const unsigned b_ = lds0 + (unsigned)(buf); \
    glds16(vt_ + voff[0], b_ + (unsigned)wid * 1024u); glds16(vt_ + voff[1], b_ + (unsigned)(wid + 8) * 1024u); } while (0)
  MLA_DMA_K(0, K_OFF0);
  bf16x8 qr[12];
  { const int tok = qb * 256 + wid * 32 + r32; const bf16_t* Qw = Qn + (size_t)tok * LDQ + h * 192 + hi * 8; float ss = 0.f;
#pragma unroll
    for (int d0 = 0; d0 < 12; ++d0) { qr[d0] = *reinterpret_cast<const bf16x8*>(Qw + d0 * 16);
#pragma unroll
      for (int e = 0; e < 8; ++e) { const float f = bf2f(qr[d0][e]); ss += f * f; } }
    { auto rr = __builtin_amdgcn_permlane32_swap(__float_as_uint(ss), __float_as_uint(ss), false, false); ss = __uint_as_float(rr[0]) + __uint_as_float(rr[1]); }
    const float rq = (LOG2E * 0.07216878364870322f) / sqrtf(ss * (1.0f / 192.0f) + 1e-6f);
#pragma unroll
    for (int d0 = 0; d0 < 8; ++d0) { const f32x4 ga = *(const f32x4*)(qg + d0 * 16 + hi * 8), gb = *(const f32x4*)(qg + d0 * 16 + hi * 8 + 4);
      u32x4 w; w.x = cvtpk(bf2f(qr[d0][0]) * rq * ga[0], bf2f(qr[d0][1]) * rq * ga[1]); w.y = cvtpk(bf2f(qr[d0][2]) * rq * ga[2], bf2f(qr[d0][3]) * rq * ga[3]);
      w.z = cvtpk(bf2f(qr[d0][4]) * rq * gb[0], bf2f(qr[d0][5]) * rq * gb[1]); w.w = cvtpk(bf2f(qr[d0][6]) * rq * gb[2], bf2f(qr[d0][7]) * rq * gb[3]);
      qr[d0] = *reinterpret_cast<bf16x8*>(&w); }
#pragma unroll
    for (int d0 = 8; d0 < 10; ++d0) { const int jj = (d0 - 8) * 16 + hi * 8;
      const f32x4 gxa = *(const f32x4*)(qg + 128 + jj), gxb = *(const f32x4*)(qg + 128 + jj + 4), gya = *(const f32x4*)(qg + 160 + jj), gyb = *(const f32x4*)(qg + 160 + jj + 4);
      const f32x4 ca = *(const f32x4*)(COS + (size_t)tok * 32 + jj), cb = *(const f32x4*)(COS + (size_t)tok * 32 + jj + 4), sa = *(const f32x4*)(SIN + (size_t)tok * 32 + jj), sb = *(const f32x4*)(SIN + (size_t)tok * 32 + jj + 4);
      float xo[8], yo[8];
#pragma unroll
      for (int e = 0; e < 8; ++e) { const float gx = e < 4 ? gxa[e] : gxb[e - 4], gy = e < 4 ? gya[e] : gyb[e - 4], c = e < 4 ? ca[e] : cb[e - 4], s = e < 4 ? sa[e] : sb[e - 4];
        const float x = bf2f(qr[d0][e]) * rq * gx, y = bf2f(qr[d0 + 2][e]) * rq * gy; xo[e] = x * c - y * s; yo[e] = y * c + x * s; }
      u32x4 wx = {cvtpk(xo[0], xo[1]), cvtpk(xo[2], xo[3]), cvtpk(xo[4], xo[5]), cvtpk(xo[6], xo[7])}, wy = {cvtpk(yo[0], yo[1]), cvtpk(yo[2], yo[3]), cvtpk(yo[4], yo[5]), cvtpk(yo[6], yo[7])};
      qr[d0] = *reinterpret_cast<bf16x8*>(&wx); qr[d0 + 2] = *reinterpret_cast<bf16x8*>(&wy); }
  }
  float m_reg = -1e30f, l_reg = 0.f; f32x16 o[4] = {};
  f32x16 p0, p1; float al = 1.f; bf16x8 pa[4] = {};
  const int vbase = (int)(lds0 + V_OFF0) + v_rd_base(lane); const ATT_LAS unsigned char* vptr = lds + V_OFF0 + v_rd_base(lane);
  ATT_WAIT_BAR();
  if (ATT_PRIO == 2 && half) __builtin_amdgcn_s_setprio(1);
  if (half) { MLA_DMA_K(1, K_OFF1); MLA_DMA_V(0, V_OFF0); ATT_BAR(); }
  if (!half) { MLA_DMA_K(1, K_OFF1); MLA_DMA_V(0, V_OFF0); }
  if (ATT_PRIO == 1) __builtin_amdgcn_s_setprio(1);
  mfma_block<false>(p0, p1, o, lds + K_OFF0, vptr, qr, pa, r32, hi);
  if (ATT_PRIO == 1) __builtin_amdgcn_s_setprio(0);
  if (half) ATT_WAIT_BAR(); else ATT_BAR();
  if (half) { MLA_DMA_K(2, K_OFF0); MLA_DMA_V(1, V_OFF1); }
  partialSM2(p0, p1, m_reg, al);
  finishSM(p0, p1, al, l_reg, pa[0], pa[1], pa[2], pa[3]);
  if (!half) ATT_WAIT_BAR();
  f32x16 negm;
#pragma unroll
  for (int r = 0; r < 16; ++r) negm[r] = -m_reg;
#pragma unroll 1
  for (int j = 1; j < NT; ++j) {
    const int kb = (j & 1) * KT, vprev = ((j + 1) & 1) * VT;
    if (!half) { if (j + 1 < NT) MLA_DMA_K(j + 1, K_OFF0 + (KT - kb)); MLA_DMA_V(j, V_OFF0 + (VT - vprev)); }
    if (ATT_PRIO == 1) __builtin_amdgcn_s_setprio(1);
    mfma_block_n<true>(p0, p1, o, lds + K_OFF0 + kb, vptr + vprev, qr, pa, r32, hi, negm);
    if (ATT_PRIO == 1) __builtin_amdgcn_s_setprio(0);
    if (half) ATT_WAIT_BAR();
    if (half) { if (j + 2 < NT) MLA_DMA_K(j + 2, K_OFF0 + kb); if (j + 1 < NT) MLA_DMA_V(j + 1, V_OFF0 + vprev); }
    if (!(MODE & 1)) { partialSM2n(p0, p1, negm, al); ATT_RESC(4, al);
    finishSM(p0, p1, al, l_reg, pa[0], pa[1], pa[2], pa[3]); }
    else { asm volatile("" : "+v"(p0), "+v"(p1)); l_reg += p0[0] + p1[5]; }
    if (!half) ATT_WAIT_BAR();
  }
  pv4(o, vbase + ((NT - 1) & 1) * VT, pa[0], pa[1], pa[2], pa[3]);
  if (ATT_PRIO == 2) __builtin_amdgcn_s_setprio(0);
  if (hi == 0) li_l[r32] = l_reg;
  ATT_WAIT_BAR();
  float rli[16];
#pragma unroll
  for (int r = 0; r < 16; ++r) rli[r] = __builtin_amdgcn_rcpf(li_l[crow(r, hi)]);
  ATT_LAS bf16_t* stg = (ATT_LAS bf16_t*)lds + wid * (32 * OST_PITCH);
#pragma unroll
  for (int r = 0; r < 16; ++r) { const int orow = crow(r, hi);
#pragma unroll
    for (int d0 = 0; d0 < 4; ++d0) { const unsigned w = cvtpk(o[d0][r] * rli[r], 0.f); stg[orow * OST_PITCH + d0 * 32 + r32] = (bf16_t)(w & 0xffffu); } }
  asm volatile("s_waitcnt lgkmcnt(0)" ::: "memory");
  bf16_t* Ow = O + (size_t)(qb * 256 + wid * 32) * LDO + h * 128;
#pragma unroll
  for (int i = 0; i < 8; ++i) { const int row = i * 4 + (lane >> 4), ch = lane & 15; const u32x4 v = *(const ATT_LAS u32x4*)(stg + row * OST_PITCH + ch * 8); *(u32x4*)(Ow + (size_t)row * LDO + ch * 8) = v; }
  ATT_WAIT_BAR();
#undef MLA_DMA_K
#undef MLA_DMA_V
}
}

namespace swa {
constexpr int S = 8192, LDQKV = 3072, LDO = 2048, NTILE = S / 64, KCOL = 2048, VCOL = 2560;
constexpr int K_OFF = 0, V_OFF = 65536, SLOT = 8192;
__device__ __forceinline__ void super_unit(ATT_LAS unsigned char* lds, ATT_LAS float* posk, ATT_LAS float* wscr, ATT_LAS unsigned char* ostage, const bf16_t* __restrict__ QKV, const int* __restrict__ positions,
                                           const float* __restrict__ qg, const float* __restrict__ kg, const float* __restrict__ sink, bf16_t* __restrict__ O, int kvh, int jb) {
  int tid = threadIdx.x; asm volatile("" : "+v"(tid));
  const int lane = tid & 63, r32 = lane & 31, hi = lane >> 5; const int wid = __builtin_amdgcn_readfirstlane(tid >> 6);
  const unsigned lds0 = (unsigned)(uintptr_t)lds;
  ATT_LAS float* al_l = wscr + wid * 64; ATT_LAS float* li_l = al_l + 32;
  const int T0 = 4 * jb - 2;
  { const int T = T0 + wid;
    if (T >= 0 && T < NTILE) {
      const bf16_t* kbase = QKV + (size_t)T * 64 * LDQKV + KCOL + kvh * 64; const bf16_t* vbase = QKV + (size_t)T * 64 * LDQKV + VCOL + kvh * 64;
#pragma unroll
      for (int pc = 0; pc < 8; ++pc) {
        const int row = pc * 8 + (lane >> 3), c = (lane & 7) ^ ((row >> 1) & 7);
        glds16(kbase + (size_t)row * LDQKV + c * 8, lds0 + K_OFF + (unsigned)wid * SLOT + (unsigned)pc * 1024u);
        const int kk = pc * 8 + ((lane & 31) >> 2), vc = (lane >> 5) * 32 + (lane & 3) * 8, k = (kk & ~0xC) | ((kk & 4) << 1) | ((kk & 8) >> 1);
        glds16(vbase + (size_t)k * LDQKV + vc, lds0 + V_OFF + (unsigned)wid * SLOT + (unsigned)pc * 1024u);
      }
    }
    const int s = 64 * T0 + tid; posk[tid] = (s >= 0 && s < S) ? (float)positions[s] : 0.f;
  }
  ATT_WAIT_BAR();
  { const int T = T0 + wid;
    if (T >= 0 && T < NTILE) {
      ATT_LAS unsigned char* rowp = lds + K_OFF + wid * SLOT + lane * 128;
      bf16x8 v[8]; float ss = 0.f;
#pragma unroll
      for (int c = 0; c < 8; ++c) { v[c] = *reinterpret_cast<const ATT_LAS bf16x8*>(rowp + (((c + (lane >> 1)) & 7) << 4));
#pragma unroll
        for (int e = 0; e < 8; ++e) { const float f = bf2f(v[c][e]); ss += f * f; } }
      const float rs = __builtin_amdgcn_rsqf(ss * (1.0f / 64.0f) + 1e-6f);
#pragma unroll
      for (int c = 0; c < 8; ++c) { u32x4 w; w.x = cvtpk(bf2f(v[c][0]) * rs, bf2f(v[c][1]) * rs); w.y = cvtpk(bf2f(v[c][2]) * rs, bf2f(v[c][3]) * rs);
        w.z = cvtpk(bf2f(v[c][4]) * rs, bf2f(v[c][5]) * rs); w.w = cvtpk(bf2f(v[c][6]) * rs, bf2f(v[c][7]) * rs); *reinterpret_cast<ATT_LAS u32x4*>(rowp + (((c + (lane >> 1)) & 7) << 4)) = w; }
    }
  }
  ATT_WAIT_BAR();
  const int g = wid >> 1, hq = 4 * kvh + g;
  const float slope2 = __builtin_amdgcn_exp2f(-0.25f * (float)(hq + 1)) * LOG2E, sink2 = sink[hq] * LOG2E;
  const int vrb = (int)(lds0 + V_OFF) + v_rd_base(lane);
#pragma unroll 1
  for (int sb = 0; sb < 4; ++sb) {
    const int tw = 256 * jb + 64 * sb + 32 * (wid & 1), t = tw + r32;
    bf16x8 qr[4];
    { const bf16_t* Qp = QKV + (size_t)t * LDQKV + hq * 64 + hi * 8; bf16x8 raw[4]; float ss = 0.f;
#pragma unroll
      for (int d0 = 0; d0 < 4; ++d0) { raw[d0] = *reinterpret_cast<const bf16x8*>(Qp + d0 * 16);
#pragma unroll
        for (int e = 0; e < 8; ++e) { const float f = bf2f(raw[d0][e]); ss += f * f; } }
      { auto rr = __builtin_amdgcn_permlane32_swap(__float_as_uint(ss), __float_as_uint(ss), false, false); ss = __uint_as_float(rr[0]) + __uint_as_float(rr[1]); }
      const float rs = __builtin_amdgcn_rsqf(ss * (1.0f / 64.0f) + 1e-6f) * (0.125f * LOG2E);
#pragma unroll
      for (int d0 = 0; d0 < 4; ++d0) { const int dd = d0 * 16 + hi * 8; const f32x4 ga = *(const f32x4*)(qg + dd), gb = *(const f32x4*)(qg + dd + 4), ka = *(const f32x4*)(kg + dd), kb = *(const f32x4*)(kg + dd + 4);
        u32x4 w; w.x = cvtpk(bf2f(raw[d0][0]) * rs * ga[0] * ka[0], bf2f(raw[d0][1]) * rs * ga[1] * ka[1]); w.y = cvtpk(bf2f(raw[d0][2]) * rs * ga[2] * ka[2], bf2f(raw[d0][3]) * rs * ga[3] * ka[3]);
        w.z = cvtpk(bf2f(raw[d0][4]) * rs * gb[0] * kb[0], bf2f(raw[d0][5]) * rs * gb[1] * kb[1]); w.w = cvtpk(bf2f(raw[d0][6]) * rs * gb[2] * kb[2], bf2f(raw[d0][7]) * rs * gb[3] * kb[3]);
        qr[d0] = *reinterpret_cast<bf16x8*>(&w); } }
    const float posq = (float)positions[t];
    float l_reg = 1.0f; f32x16 o[2] = {};
    f32x16 negm;
#pragma unroll
    for (int r = 0; r < 16; ++r) negm[r] = -sink2;
#pragma unroll 1
    for (int lt = sb; lt < sb + 5; ++lt) {
      const int T = T0 + lt; if (T < 0 || T >= NTILE) continue;
      f32x16 p0, p1;
      { const ATT_LAS unsigned char* kb = lds + K_OFF + lt * SLOT + r32 * 128; const int sw = ((r32 >> 1) & 7) << 4;
#pragma unroll
        for (int d0 = 0; d0 < 4; ++d0) { const int cb = (d0 * 32 + hi * 16) ^ sw;
          const bf16x8 b0 = *reinterpret_cast<const ATT_LAS bf16x8*>(kb + cb); const bf16x8 b1 = *reinterpret_cast<const ATT_LAS bf16x8*>(kb + 4096 + cb);
          p0 = __builtin_amdgcn_mfma_f32_32x32x16_bf16(b0, qr[d0], d0 == 0 ? negm : p0, 0, 0, 0); p1 = __builtin_amdgcn_mfma_f32_32x32x16_bf16(b1, qr[d0], d0 == 0 ? negm : p1, 0, 0, 0); } }
      if (64 * T - tw >= -97 && 64 * T - tw <= 65)
      { const ATT_LAS float* pk = posk + 64 * lt + 4 * hi;
#pragma unroll
        for (int q4 = 0; q4 < 4; ++q4) { const f32x4 k0 = *reinterpret_cast<const ATT_LAS f32x4*>(pk + 8 * q4), k1 = *reinterpret_cast<const ATT_LAS f32x4*>(pk + 32 + 8 * q4);
#pragma unroll
          for (int e = 0; e < 4; ++e) { const int r = 4 * q4 + e;
            const float s0 = p0[r] - slope2 * fabsf(posq - k0[e]), s1 = p1[r] - slope2 * fabsf(posq - k1[e]);
            p0[r] = s0; p1[r] = s1; } } }
      else
      { const int delta = 64 * T - t + 4 * hi; const ATT_LAS float* pk = posk + 64 * lt + 4 * hi;
#pragma unroll
        for (int q4 = 0; q4 < 4; ++q4) { const f32x4 k0 = *reinterpret_cast<const ATT_LAS f32x4*>(pk + 8 * q4), k1 = *reinterpret_cast<const ATT_LAS f32x4*>(pk + 32 + 8 * q4);
#pragma unroll
          for (int e = 0; e < 4; ++e) { const int r = 4 * q4 + e, rel0 = delta + 8 * q4 + e, rel1 = rel0 + 32;
            const float s0 = p0[r] - slope2 * fabsf(posq - k0[e]), s1 = p1[r] - slope2 * fabsf(posq - k1[e]);
            p0[r] = ((unsigned)(rel0 + 128) <= 256u) ? s0 : -1e30f; p1[r] = ((unsigned)(rel1 + 128) <= 256u) ? s1 : -1e30f; } } }
      float al; bf16x8 pa0, pa1, pa2, pa3;
      partialSM2n(p0, p1, negm, al); ATT_RESC(2, al);
      finishSM(p0, p1, al, l_reg, pa0, pa1, pa2, pa3); ATT_SBAR();
      pv_one<2, 0>(o[0], vrb + lt * SLOT, pa0, pa1, pa2, pa3); pv_one<2, 1>(o[1], vrb + lt * SLOT, pa0, pa1, pa2, pa3);
    }
    if (hi == 0) li_l[r32] = l_reg; asm volatile("s_waitcnt lgkmcnt(0)" ::: "memory");
    bf16_t* Ow = O + (size_t)tw * LDO + hq * 64;
    ATT_LAS bf16_t* stg = (ATT_LAS bf16_t*)(ostage + wid * 1024);
#pragma unroll
    for (int gq = 0; gq < 4; ++gq) {
#pragma unroll
      for (int e = 0; e < 4; ++e) { const int r = 4 * gq + e; const float rl = __builtin_amdgcn_rcpf(li_l[crow(r, hi)]);
#pragma unroll
        for (int d0 = 0; d0 < 2; ++d0) { const unsigned w = cvtpk(o[d0][r] * rl, 0.f); stg[(e + 4 * hi) * 64 + d0 * 32 + r32] = (bf16_t)(w & 0xffffu); } }
      asm volatile("s_waitcnt lgkmcnt(0)" ::: "memory");
      { const int row = lane >> 3, ch = lane & 7; const u32x4 v = *(const ATT_LAS u32x4*)(stg + row * 64 + ch * 8); *(u32x4*)(Ow + (size_t)(8 * gq + row) * LDO + ch * 8) = v; }
      asm volatile("s_waitcnt lgkmcnt(0)" ::: "memory");
    }
    asm volatile("s_waitcnt lgkmcnt(0)" ::: "memory");
  }
  ATT_WAIT_BAR();
}
}
}
constexpr int NWAVES = 8;
constexpr int S_ = 8192, DM = 2048, DFF = 5632, DEPTH = 4;
constexpr int MLA_NA = 1088, MLA_NA_PAD = 1280, MLA_NQ = 3072, MLA_NKV = 4096, MLA_R = 512;
constexpr int SWA_NQKV = 3072;
constexpr float RMS_EPS = 1e-6f;
#ifndef TEST_PROG
#define TEST_PROG 6
#endif
#ifndef MLA_UNIT
#define MLA_UNIT unit_softn
#endif
#ifndef PROBE_MODE
#define PROBE_MODE 0
#endif
#ifndef PROBE_REP
#define PROBE_REP 0
#endif
#ifndef MK_PER_PHASE
#define MK_PER_PHASE 0
#endif

constexpr size_t MiB = 1u << 20;
constexpr size_t WS_CTL = 0, CTL_ZERO_BYTES = 1 * MiB;
constexpr size_t WS_COS = 1 * MiB, WS_SIN = 2 * MiB;
constexpr size_t WS_WFFN = 4 * MiB, FFN_STRIDE = 66 * MiB, FFN_WD_OFF = 44 * MiB;
constexpr size_t WS_WMLA = WS_WFFN + 8 * FFN_STRIDE, MLA_STRIDE = 20 * MiB, MLA_WUQ_OFF = 5 * MiB, MLA_WUKV_OFF = 8 * MiB, MLA_WO_OFF = 12 * MiB;
constexpr size_t WS_WSWA = WS_WMLA + 2 * MLA_STRIDE, SWA_STRIDE = 20 * MiB, SWA_WO_OFF = 12 * MiB;
constexpr size_t WS_XN = WS_WSWA + 2 * SWA_STRIDE;
constexpr size_t WS_ACT = WS_XN + 32 * MiB;
constexpr size_t WS_SSA = WS_ACT + 88 * MiB;
constexpr size_t WS_KPE = WS_SSA + 1 * MiB;
constexpr size_t WS_CQN = WS_KPE + 2 * MiB, WS_CKVN = WS_CQN + 8 * MiB;
constexpr size_t WS_Q = WS_CKVN + 8 * MiB;
constexpr size_t WS_KV = WS_Q + 48 * MiB;
constexpr size_t WS_KN = WS_KV + 64 * MiB;
constexpr size_t WS_O = WS_KN + 48 * MiB;
constexpr size_t WS_XS = WS_O + 32 * MiB;
constexpr size_t WS_END = WS_XS + 32 * MiB;
constexpr int CW_BAR = 4096;
constexpr size_t CTL_USED_BYTES = 32768;

constexpr int RING_OFF = 0, RING_BYTES = 131072;
constexpr int LDSCTL_OFF = RING_BYTES, MISC_OFF = LDSCTL_OFF + 320;
constexpr int POSK_OFF = RING_BYTES + 1024;
constexpr int WSCR_OFF = RING_BYTES + 4096;
constexpr int RSTAB_OFF = RING_BYTES + 8192;
constexpr int LDS_BYTES = 147456;
static_assert(att::mla::LDS_END <= RING_BYTES && WSCR_OFF + 8 * 256 <= LDS_BYTES && MISC_OFF + 128 <= POSK_OFF && WSCR_OFF + 8 * 256 <= RSTAB_OFF && RSTAB_OFF + 8192 <= LDS_BYTES, "LDS map");

#define GAS __attribute__((address_space(1)))
#define LAS __attribute__((address_space(3)))
typedef unsigned short bf16;
typedef unsigned v4u __attribute__((ext_vector_type(4)));
typedef float f32x4 __attribute__((ext_vector_type(4)));
typedef short bf16x8 __attribute__((ext_vector_type(8)));
typedef GAS unsigned gu32;
typedef GAS unsigned long long gu64;
#define RLX_AGENT __ATOMIC_RELAXED, __HIP_MEMORY_SCOPE_AGENT
#define LDS_WAIT() asm volatile("s_waitcnt lgkmcnt(0)" ::: "memory")
#define VM_WAIT() asm volatile("s_waitcnt vmcnt(0)" ::: "memory")
__device__ __forceinline__ unsigned long long rt() { return __builtin_amdgcn_s_memrealtime(); }
__device__ __forceinline__ unsigned f2bf(float f) { unsigned u = __builtin_bit_cast(unsigned, f); return (u + 0x7fffu + ((u >> 16) & 1u)) >> 16; }
__device__ __forceinline__ unsigned pk2(float lo, float hi) { return f2bf(lo) | (f2bf(hi) << 16); }

#define XB_TMO      128
#define XB_XCNT(j)  (256  + 64 * (j))
#define XB_XSUB(j)  (1280 + 64 * (j))
#define XB_XGEN(j)  (2304 + 64 * (j))
#define XB_TOP      3328
#define XB_TOPGEN   3392
#define XCD_BAR_WORDS 3456
#define XB_SPIN_CAP (1u << 18)

__device__ __forceinline__ unsigned xb_ld(unsigned* p)              { return __hip_atomic_load(p, __ATOMIC_RELAXED, __HIP_MEMORY_SCOPE_AGENT); }
__device__ __forceinline__ unsigned xb_add(unsigned* p, unsigned v) { return __hip_atomic_fetch_add(p, v, __ATOMIC_RELAXED, __HIP_MEMORY_SCOPE_AGENT); }
__device__ __forceinline__ unsigned xb_xcc_id() { return (unsigned)__builtin_amdgcn_s_getreg((3 << 11) | 20) & 0xFu; }
#define XB_SPIN(cond, bar) do { unsigned _sp = 0; while (cond) { __builtin_amdgcn_s_sleep(1); \
    if ((++_sp & 255u) == 0u) { if (xb_ld(&(bar)[XB_TMO])) break; if (_sp > XB_SPIN_CAP) { atomicAdd(&(bar)[XB_TMO], 1u); break; } } } } while (0)

struct XcdBarrier {
    unsigned* bar; unsigned x;
    volatile LAS unsigned* st;
};

__device__ __forceinline__ XcdBarrier xcd_barrier_post(unsigned* bar, volatile LAS unsigned* st) {
    XcdBarrier b; b.bar = bar; b.x = xb_xcc_id(); b.st = st;
    if (threadIdx.x == 0) (void)xb_add(&bar[XB_XCNT(b.x)], 1u);
    return b;
}
__device__ __forceinline__ void xcd_barrier_complete(unsigned* bar, unsigned x, unsigned& nloc, unsigned& nx) {
    const unsigned G = gridDim.x * gridDim.y * gridDim.z;
    unsigned sum, cnt, mine, sp = 0u;
    for (;;) {
        sum = 0u; cnt = 0u; mine = 0u;
#pragma unroll
        for (unsigned j = 0; j < 16; ++j) { const unsigned c = xb_ld(&bar[XB_XCNT(j)]); sum += c; cnt += (c > 0u) ? 1u : 0u; mine = (j == x) ? c : mine; }
        if (sum == G) break;
        __builtin_amdgcn_s_sleep(1);
        if ((++sp & 255u) == 0u) { if (xb_ld(&bar[XB_TMO])) break; if (sp > XB_SPIN_CAP) { atomicAdd(&bar[XB_TMO], 1u); break; } }
    }
    nloc = mine > 0u ? mine : 1u; nx = cnt > 0u ? cnt : 1u;
}

__device__ __forceinline__ void xcd_barrier(const XcdBarrier& b) {
    asm volatile("s_waitcnt vmcnt(0)" ::: "memory");
    __syncthreads();
    if (threadIdx.x == 0) {
        unsigned* bar = b.bar;
        __builtin_amdgcn_s_waitcnt(0);
        unsigned nloc = b.st[0], nx = b.st[1];
        if (nloc == 0u) { xcd_barrier_complete(bar, b.x, nloc, nx); b.st[0] = nloc; b.st[1] = nx; }
        const unsigned old = xb_add(&bar[XB_XSUB(b.x)], 1u);
        const unsigned gen = old / nloc;
        if (old + 1u == (gen + 1u) * nloc) {
            __builtin_amdgcn_fence(__ATOMIC_RELEASE, "agent");
            asm volatile("s_waitcnt vmcnt(0)" ::: "memory");
            const unsigned og = xb_add(&bar[XB_TOP], 1u);
            const unsigned tg = og / nx;
            if (og + 1u == (tg + 1u) * nx) xb_add(&bar[XB_TOPGEN], 1u);
            else XB_SPIN(xb_ld(&bar[XB_TOPGEN]) == tg, bar);
            __builtin_amdgcn_fence(__ATOMIC_ACQUIRE, "agent");
            xb_add(&bar[XB_XGEN(b.x)], 1u);
            asm volatile("s_waitcnt vmcnt(0)" ::: "memory");
        } else {
            XB_SPIN(xb_ld(&bar[XB_XGEN(b.x)]) == gen, bar);
            __builtin_amdgcn_fence(__ATOMIC_ACQUIRE, "agent");
            asm volatile("s_waitcnt vmcnt(0)" ::: "memory");
        }
    }
    __syncthreads();
}
struct Frame {
    LAS unsigned char* lds;
    volatile LAS unsigned* MISC;
    gu32* ctl;
    int tid, lane, wave;
    int vcu, G;
    unsigned char* ws;
    const float* x_in; const int* positions; const float* norm_g;
    const float *ffn_wg, *ffn_wu, *ffn_wd;
    const float *mla_wa, *mla_qag, *mla_kvag, *mla_wuq, *mla_wukv, *mla_qg, *mla_kg, *mla_wo;
    const float *swa_wqkv, *swa_qg, *swa_kg, *swa_sink, *swa_wo;
    float* out;
};

__device__ __forceinline__ float wave_sum(float v) {
#pragma unroll
    for (int o = 1; o < 64; o <<= 1) v += __shfl_xor(v, o);
    return v;
}
__device__ __forceinline__ float sum16(float v) {
#pragma unroll
    for (int o = 1; o < 16; o <<= 1) v += __shfl_xor(v, o);
    return v;
}
__device__ __forceinline__ float bf2f_u(unsigned short x) { return __uint_as_float(((unsigned)x) << 16); }

__device__ __forceinline__ void transpose_item(const float* W, int K, int N, bf16* WT, int mode, LAS float* scr, int item, int lane) {
    const int nblk = N / 32, kb = item / nblk, nb = item % nblk, k0 = 64 * kb, n0 = 32 * nb;
    const int drow0 = (mode == 0) ? n0 : ((n0 >> 7) * 256 + (mode - 1) * 128 + (n0 & 127));
#pragma unroll 8
    for (int i = 0; i < 32; ++i) { const int kk = 2 * i + (lane >> 5); scr[kk * 33 + (lane & 31)] = W[(size_t)(k0 + kk) * N + n0 + (lane & 31)]; }
    LDS_WAIT(); asm volatile("" ::: "memory");
    const int c = lane & 7;
#pragma unroll
    for (int j = 0; j < 4; ++j) { const int n = (lane >> 3) + 8 * j; const LAS float* s = scr + (8 * c) * 33 + n;
        v4u o; o.x = pk2(s[0 * 33], s[1 * 33]); o.y = pk2(s[2 * 33], s[3 * 33]); o.z = pk2(s[4 * 33], s[5 * 33]); o.w = pk2(s[6 * 33], s[7 * 33]);
        *(GAS v4u*)(WT + (size_t)(drow0 + n) * K + k0 + 8 * c) = o; }
    LDS_WAIT(); asm volatile("" ::: "memory");
}

__device__ __forceinline__ void transpose_item64(const float* W, int K, int N, bf16* WT, int mode, LAS unsigned char* scr, int item, int lane, const float* gk = nullptr) {
    const int nblk = N / 64, kb = item / nblk, nb = item % nblk, k0 = 64 * kb, n0 = 64 * nb;
    const int drow0 = (mode == 0) ? n0 : ((n0 >> 7) * 256 + (mode - 1) * 128 + (n0 & 127));
    const int p = lane & 15, q = lane >> 4;
    const float* wp = W + (size_t)(k0 + 2 * q) * N + n0 + 4 * p;
    f32x4 a[8], b[8];
#pragma unroll
    for (int i = 0; i < 8; ++i) { a[i] = __builtin_nontemporal_load((const f32x4*)(wp + (size_t)(8 * i) * N)); b[i] = __builtin_nontemporal_load((const f32x4*)(wp + (size_t)(8 * i + 1) * N)); }
    if (gk) {
#pragma unroll
        for (int i = 0; i < 8; ++i) { const pg8::f32x2 gg = *(const pg8::f32x2*)(gk + k0 + 8 * i + 2 * q); a[i] = a[i] * gg[0]; b[i] = b[i] * gg[1]; } }
#pragma unroll
    for (int i = 0; i < 8; ++i)
#pragma unroll
        for (int e = 0; e < 4; ++e) *(LAS unsigned*)(scr + (4 * p + e) * 132 + 2 * (8 * i + 2 * q)) = pg8::cvt_pk_bf16(a[i][e], b[i][e]);
    LDS_WAIT(); asm volatile("" ::: "memory");
    const int c = lane & 7;
#pragma unroll
    for (int j = 0; j < 8; ++j) { const int n = (lane >> 3) + 8 * j; const LAS unsigned* s = (const LAS unsigned*)(scr + n * 132 + 16 * c);
        v4u o; o.x = s[0]; o.y = s[1]; o.z = s[2]; o.w = s[3];
        *(GAS v4u*)(WT + (size_t)(drow0 + n) * K + k0 + 8 * c) = o; }
    LDS_WAIT(); asm volatile("" ::: "memory");
}

constexpr int I_GU = (DM / 64) * (DFF / 64), I_D = (DFF / 64) * (DM / 64), I_FFN = 2 * I_GU + I_D;
constexpr int I_A = (DM / 64) * (MLA_NA / 64), I_UQ = (MLA_R / 64) * (MLA_NQ / 64), I_UKV = (MLA_R / 64) * (MLA_NKV / 64), I_O = (DM / 64) * (DM / 64), I_MLA = I_A + I_UQ + I_UKV + I_O;
constexpr int I_QKV = (DM / 64) * (SWA_NQKV / 64), I_SWA = I_QKV + I_O;
__host__ __device__ constexpr int layer_items(int L) { return 2 * I_FFN + ((L & 1) ? I_SWA : I_MLA); }
__device__ __forceinline__ void convert_layer_item(Frame& F, int L, int r, LAS unsigned char* scr) {
    if (r < 2 * I_FFN) { const int f = 2 * L + r / I_FFN; r %= I_FFN;
        bf16* wgu = (bf16*)(F.ws + WS_WFFN + (size_t)f * FFN_STRIDE); bf16* wd = (bf16*)(F.ws + WS_WFFN + (size_t)f * FFN_STRIDE + FFN_WD_OFF);
        if (r < I_GU) { transpose_item64(F.ffn_wg + (size_t)f * DM * DFF, DM, DFF, wgu, 1, scr, r, F.lane); return; } r -= I_GU;
        if (r < I_GU) { transpose_item64(F.ffn_wu + (size_t)f * DM * DFF, DM, DFF, wgu, 2, scr, r, F.lane); return; } r -= I_GU;
        transpose_item64(F.ffn_wd + (size_t)f * DFF * DM, DFF, DM, wd, 0, scr, r, F.lane); return; }
    r -= 2 * I_FFN; const int j = L >> 1;
    if ((L & 1) == 0) { unsigned char* wb = F.ws + WS_WMLA + (size_t)j * MLA_STRIDE;
        if (r < I_A) { transpose_item64(F.mla_wa + (size_t)j * DM * MLA_NA, DM, MLA_NA, (bf16*)wb, 0, scr, r, F.lane); return; } r -= I_A;
        if (r < I_UQ) { transpose_item64(F.mla_wuq + (size_t)j * MLA_R * MLA_NQ, MLA_R, MLA_NQ, (bf16*)(wb + MLA_WUQ_OFF), 0, scr, r, F.lane, F.mla_qag + j * MLA_R); return; } r -= I_UQ;
        if (r < I_UKV) { transpose_item64(F.mla_wukv + (size_t)j * MLA_R * MLA_NKV, MLA_R, MLA_NKV, (bf16*)(wb + MLA_WUKV_OFF), 0, scr, r, F.lane, F.mla_kvag + j * MLA_R); return; } r -= I_UKV;
        transpose_item64(F.mla_wo + (size_t)j * DM * DM, DM, DM, (bf16*)(wb + MLA_WO_OFF), 0, scr, r, F.lane); return; }
    { unsigned char* wb = F.ws + WS_WSWA + (size_t)j * SWA_STRIDE;
        if (r < I_QKV) { transpose_item64(F.swa_wqkv + (size_t)j * DM * SWA_NQKV, DM, SWA_NQKV, (bf16*)wb, 0, scr, r, F.lane); return; } r -= I_QKV;
        transpose_item64(F.swa_wo + (size_t)j * DM * DM, DM, DM, (bf16*)(wb + SWA_WO_OFF), 0, scr, r, F.lane); }
}
#ifndef TAIL_NA
#define TAIL_NA 48
#endif
#ifndef TAIL_NC
#define TAIL_NC 48
#endif
#ifndef TAIL_NB_M
#define TAIL_NB_M 72
#endif
#ifndef TAIL_NB_S
#define TAIL_NB_S 48
#endif
__host__ __device__ constexpr int mix_items(int L) { return (L & 1) ? I_SWA : I_MLA; }
__host__ __device__ constexpr int stream_len(int L) { return I_FFN + (L < 3 ? I_FFN + mix_items(L + 1) : 0); }
__host__ __device__ constexpr int tail_b_items(int L) { return (L & 1) ? 128 * TAIL_NB_S : 96 * TAIL_NB_M; }
__host__ __device__ constexpr int tail_cap(int L) { return 128 * TAIL_NA + tail_b_items(L) + 128 * TAIL_NC; }
__host__ __device__ constexpr int tail_covered(int L) { return tail_cap(L) < stream_len(L) ? tail_cap(L) : stream_len(L); }
static_assert(128 * TAIL_NA + tail_b_items(0) >= I_FFN && 128 * TAIL_NA + tail_b_items(1) >= I_FFN, "slots A + B must cover the layer's own post-FFN weights");
__device__ __forceinline__ void convert_stream_entry(Frame& F, int L, int r, LAS unsigned char* scr) {
    if (r < I_FFN) convert_layer_item(F, L, I_FFN + r, scr);
    else convert_layer_item(F, L + 1, r < 2 * I_FFN ? r - I_FFN : r, scr);
}
__device__ __forceinline__ void tail_convert(Frame& F, int L, int slot) {
    if (F.G != 256) return;
    const int c = (int)blockIdx.x; int first_idle = 128, per = TAIL_NA, base = 0;
    if (slot == 1) { base = 128 * TAIL_NA; if (L & 1) { per = TAIL_NB_S; } else { first_idle = 160; per = TAIL_NB_M; } }
    else if (slot == 2) { base = 128 * TAIL_NA + tail_b_items(L); per = TAIL_NC; }
    if (c < first_idle) return;
    LAS unsigned char* scr = F.lds + RING_OFF + F.wave * 16384;
    const int start = base + (c - first_idle) * per, n = stream_len(L);
    for (int r = start + F.wave; r < start + per && r < n; r += NWAVES) convert_stream_entry(F, L, r, scr);
}

__device__ __forceinline__ void p_prologue(Frame& F) {
    LAS unsigned char* scr = F.lds + RING_OFF + F.wave * 16384;
    const int gw = F.vcu * NWAVES + F.wave, NGW = F.G * NWAVES;
    const bool tails = (F.G == 256);
    const int c0 = tails ? tail_covered(0) : 0, c1 = tails ? tail_covered(1) : 0, c2 = tails ? tail_covered(2) : 0, c3 = tails ? tail_covered(3) : 0;
    const int n0 = I_FFN + I_MLA, r0 = stream_len(0) - c0, r1 = stream_len(1) - c1, r2 = stream_len(2) - c2, r3 = stream_len(3) - c3;
    for (int it = gw; it < n0 + r0 + r1 + r2 + r3; it += NGW) {
        int r = it;
        if (r < n0) { convert_layer_item(F, 0, r < I_FFN ? r : I_FFN + r, scr); continue; } r -= n0;
        if (r < r0) { convert_stream_entry(F, 0, c0 + r, scr); continue; } r -= r0;
        if (r < r1) { convert_stream_entry(F, 1, c1 + r, scr); continue; } r -= r1;
        if (r < r2) { convert_stream_entry(F, 2, c2 + r, scr); continue; } r -= r2;
        convert_stream_entry(F, 3, c3 + r, scr);
    }
    { const int gt = F.vcu * (NWAVES * 64) + F.tid, NGT = F.G * NWAVES * 64;
      for (int i = gt; i < 2 * 49152; i += NGT) { const int j = i / 49152, r = i % 49152;
          *(GAS v4u*)(F.ws + WS_WMLA + (size_t)j * MLA_STRIDE + (size_t)MLA_NA * DM * 2 + (size_t)r * 16) = (v4u){0u, 0u, 0u, 0u}; }
      float* COS = (float*)(F.ws + WS_COS); float* SIN = (float*)(F.ws + WS_SIN);
      for (int i = gt; i < S_ * 32; i += NGT) { const int t = i >> 5, j = i & 31;
          const float inv_freq = 1.0f / powf(10000.0f, (float)(2 * j) * (1.0f / 64.0f));
          const float ang = (float)F.positions[t] * inv_freq;
          const double turns = (double)ang * 0.15915494309189533577; const double fr = turns - rint(turns);
          const float frf = (float)fr;
          COS[i] = __builtin_amdgcn_cosf(frf); SIN[i] = __builtin_amdgcn_sinf(frf); }
    }
}

typedef _Float16 f16x4_t __attribute__((ext_vector_type(4)));
template <bool XH> __device__ __forceinline__ void p_norm(Frame& F, const void* x, const float* g, bf16* xn) {
    const int gw = F.vcu * NWAVES + F.wave, NGW = F.G * NWAVES;
    f32x4 gv[8];
#pragma unroll
    for (int j = 0; j < 8; ++j) gv[j] = ((const GAS f32x4*)g)[F.lane + 64 * j];
    for (int m = gw; m < S_; m += NGW) {
        f32x4 v[8]; float s2 = 0.f;
        if (XH) { const GAS f16x4_t* xr = (const GAS f16x4_t*)((const _Float16*)x + (size_t)m * DM) + F.lane;
#pragma unroll
            for (int j = 0; j < 8; ++j) { const f16x4_t h = xr[64 * j]; v[j] = (f32x4){(float)h[0], (float)h[1], (float)h[2], (float)h[3]}; } }
        else { const GAS f32x4* xr = (const GAS f32x4*)((const float*)x + (size_t)m * DM) + F.lane;
#pragma unroll
            for (int j = 0; j < 8; ++j) v[j] = xr[64 * j]; }
#pragma unroll
        for (int j = 0; j < 8; ++j) s2 += (v[j].x * v[j].x + v[j].y * v[j].y) + (v[j].z * v[j].z + v[j].w * v[j].w);
        const float rstd = 1.0f / sqrtf(wave_sum(s2) * (1.f / DM) + RMS_EPS);
        GAS unsigned long long* o8 = (GAS unsigned long long*)(xn + (size_t)m * DM) + F.lane;
#pragma unroll
        for (int j = 0; j < 8; ++j) { const f32x4 y = v[j] * rstd * gv[j]; o8[64 * j] = (unsigned long long)pk2(y.x, y.y) | ((unsigned long long)pk2(y.z, y.w) << 32); }
    }
}

__device__ __forceinline__ void p_mla_mid(Frame& F, const float* H, const float* qag, const float* kvag, bf16* cqn, bf16* ckvn) {
    const int gw = F.vcu * NWAVES + F.wave, NGW = F.G * NWAVES;
    const f32x4 ga0 = ((const GAS f32x4*)qag)[F.lane], ga1 = ((const GAS f32x4*)qag)[64 + F.lane], gb0 = ((const GAS f32x4*)kvag)[F.lane], gb1 = ((const GAS f32x4*)kvag)[64 + F.lane];
    for (int m = gw; m < S_; m += NGW) {
        const GAS f32x4* hr = (const GAS f32x4*)(H + (size_t)m * MLA_NA_PAD) + F.lane;
        const f32x4 a0 = hr[0], a1 = hr[64], b0 = hr[128], b1 = hr[192];
        const float sa = wave_sum((a0.x * a0.x + a0.y * a0.y) + (a0.z * a0.z + a0.w * a0.w) + (a1.x * a1.x + a1.y * a1.y) + (a1.z * a1.z + a1.w * a1.w));
        const float sb = wave_sum((b0.x * b0.x + b0.y * b0.y) + (b0.z * b0.z + b0.w * b0.w) + (b1.x * b1.x + b1.y * b1.y) + (b1.z * b1.z + b1.w * b1.w));
        const float ra = 1.0f / sqrtf(sa * (1.f / 512.f) + RMS_EPS), rb = 1.0f / sqrtf(sb * (1.f / 512.f) + RMS_EPS);
        GAS unsigned long long* oa = (GAS unsigned long long*)(cqn + (size_t)m * MLA_R) + F.lane; GAS unsigned long long* ob = (GAS unsigned long long*)(ckvn + (size_t)m * MLA_R) + F.lane;
        { const f32x4 y = a0 * ra * ga0; oa[0] = (unsigned long long)pk2(y.x, y.y) | ((unsigned long long)pk2(y.z, y.w) << 32); }
        { const f32x4 y = a1 * ra * ga1; oa[64] = (unsigned long long)pk2(y.x, y.y) | ((unsigned long long)pk2(y.z, y.w) << 32); }
        { const f32x4 y = b0 * rb * gb0; ob[0] = (unsigned long long)pk2(y.x, y.y) | ((unsigned long long)pk2(y.z, y.w) << 32); }
        { const f32x4 y = b1 * rb * gb1; ob[64] = (unsigned long long)pk2(y.x, y.y) | ((unsigned long long)pk2(y.z, y.w) << 32); }
    }
}

struct KPrepIn { v4u kn[4]; float c0, c1, s0, s1, ka0, ka1, kb0, kb1; };
__device__ __forceinline__ void p_mla_prep(Frame& F, const bf16* __restrict__ KV, const float* __restrict__ H, const float* __restrict__ kg, bf16* __restrict__ KN) {
    const int gw = F.vcu * NWAVES + F.wave, NGW = F.G * NWAVES; const int i16 = F.lane & 15, hsub = F.lane >> 4;
    const float* COS = (const float*)(F.ws + WS_COS); const float* SIN = (const float*)(F.ws + WS_SIN);
    const f32x4 kg0 = *(const f32x4*)(kg + 8 * i16), kg1 = *(const f32x4*)(kg + 8 * i16 + 4);
    const float kgr[4] = {kg[128 + 2 * i16], kg[129 + 2 * i16], kg[160 + 2 * i16], kg[161 + 2 * i16]};
    auto load = [&](int t, KPrepIn& in) {
        in.c0 = COS[t * 32 + 2 * i16]; in.c1 = COS[t * 32 + 2 * i16 + 1]; in.s0 = SIN[t * 32 + 2 * i16]; in.s1 = SIN[t * 32 + 2 * i16 + 1];
        const float* kpe = H + (size_t)t * 64;
        in.ka0 = kpe[2 * i16]; in.ka1 = kpe[2 * i16 + 1]; in.kb0 = kpe[32 + 2 * i16]; in.kb1 = kpe[33 + 2 * i16];
#pragma unroll
        for (int pass = 0; pass < 4; ++pass) in.kn[pass] = *(const GAS v4u*)(KV + (size_t)t * MLA_NKV + (pass * 4 + hsub) * 256 + 8 * i16); };
    auto finish = [&](int t, const KPrepIn& in) {
        const float ss_pe = sum16((in.ka0 * in.ka0 + in.ka1 * in.ka1) + (in.kb0 * in.kb0 + in.kb1 * in.kb1));
        const float px0 = in.ka0 * kgr[0], px1 = in.ka1 * kgr[1], py0 = in.kb0 * kgr[2], py1 = in.kb1 * kgr[3];
        const float rx0 = px0 * in.c0 - py0 * in.s0, rx1 = px1 * in.c1 - py1 * in.s1, ry0 = py0 * in.c0 + px0 * in.s0, ry1 = py1 * in.c1 + px1 * in.s1;
#pragma unroll
        for (int pass = 0; pass < 4; ++pass) { const int h = pass * 4 + hsub; const v4u kn = in.kn[pass];
            float kf[8] = {bf2f_u((unsigned short)kn.x), bf2f_u((unsigned short)(kn.x >> 16)), bf2f_u((unsigned short)kn.y), bf2f_u((unsigned short)(kn.y >> 16)),
                           bf2f_u((unsigned short)kn.z), bf2f_u((unsigned short)(kn.z >> 16)), bf2f_u((unsigned short)kn.w), bf2f_u((unsigned short)(kn.w >> 16))};
            float sk = 0.f;
#pragma unroll
            for (int e = 0; e < 8; ++e) sk += kf[e] * kf[e];
            const float rk = 1.0f / sqrtf((sum16(sk) + ss_pe) * (1.f / 192.f) + RMS_EPS);
            bf16* kp = KN + (size_t)t * MLA_NQ + h * 192;
            { v4u o; o.x = pk2(kf[0] * rk * kg0.x, kf[1] * rk * kg0.y); o.y = pk2(kf[2] * rk * kg0.z, kf[3] * rk * kg0.w); o.z = pk2(kf[4] * rk * kg1.x, kf[5] * rk * kg1.y); o.w = pk2(kf[6] * rk * kg1.z, kf[7] * rk * kg1.w);
              *(GAS v4u*)(kp + 8 * i16) = o; }
            *(GAS unsigned*)(kp + 128 + 2 * i16) = pk2(rx0 * rk, rx1 * rk); *(GAS unsigned*)(kp + 160 + 2 * i16) = pk2(ry0 * rk, ry1 * rk);
        } };
    int t0 = gw; if (t0 >= S_) return;
    KPrepIn A, B; load(t0, A);
    for (;;) {
        const int t1 = t0 + NGW; const bool h1 = t1 < S_;
        if (h1) load(t1, B);
        finish(t0, A);
        if (!h1) break;
        t0 = t1 + NGW; const bool h0 = t0 < S_;
        if (h0) load(t0, A);
        finish(t1, B);
        if (!h0) break;
    }
}

struct Ctx { int pid, lo, hi; XcdBarrier bar; };
#define PH_ON() (C.pid >= C.lo && C.pid < C.hi)
#define PH_END() do { if (C.pid >= C.lo && C.pid + 1 < C.hi) xcd_barrier(C.bar); ++C.pid; } while (0)
#define WS_PTRS() bf16* XN = (bf16*)(F.ws + WS_XN); bf16* ACT = (bf16*)(F.ws + WS_ACT); float* SSA = (float*)(F.ws + WS_SSA); float* KPE = (float*)(F.ws + WS_KPE); const LAS float* RSTAB = (const LAS float*)(F.lds + RSTAB_OFF); \
    bf16* CQN = (bf16*)(F.ws + WS_CQN); bf16* CKVN = (bf16*)(F.ws + WS_CKVN); bf16* Q = (bf16*)(F.ws + WS_Q); bf16* KV = (bf16*)(F.ws + WS_KV); bf16* KN = (bf16*)(F.ws + WS_KN); bf16* OB = (bf16*)(F.ws + WS_O); _Float16* XS = (_Float16*)(F.ws + WS_XS); \
    (void)XN; (void)ACT; (void)SSA; (void)KPE; (void)RSTAB; (void)CQN; (void)CKVN; (void)Q; (void)KV; (void)KN; (void)OB; (void)XS

template <int NSLOTS> __device__ __forceinline__ void build_rstd(Frame& F, const pg8::StaticOrder& So, const float* ss, int ld, int slot0, float inv_n) {
    pg8::Unit u0; const bool any = So.next(0, u0);
    if (any) { LAS float* tab = (LAS float*)(F.lds + RSTAB_OFF); const int g = u0.pm >> 3;
#pragma unroll
        for (int k = 0; k < 4; ++k) { const int r = F.tid + 512 * k; const float* p = ss + (size_t)(g * 2048 + r) * ld + slot0; float s = 0.f;
#pragma unroll
            for (int q4 = 0; q4 < NSLOTS / 4; ++q4) { const f32x4 v = *(const f32x4*)(p + 4 * q4); s += (v.x + v.y) + (v.z + v.w); }
            tab[r] = __builtin_amdgcn_rsqf(s * inv_n + RMS_EPS); } }
    __syncthreads();
}

__device__ __forceinline__ void ffn_block(Frame& F, Ctx& C, int L, int part) {
    WS_PTRS();
    const float* gL = F.norm_g + (size_t)L * 3 * DM;
    const int f = L * 2 + (part >> 1);
    const bool first = (L == 0 && part == 0), last = (L == DEPTH - 1 && part == 2);
    if (!first) { if (PH_ON()) p_norm<true>(F, XS, gL + part * DM, XN); PH_END(); }
    if (PH_ON()) { pg8::Gemm g{XN, (const bf16*)(F.ws + WS_WFFN + (size_t)f * FFN_STRIDE), S_, 2 * DFF, DM}; pg8::StaticOrder So; So.init(S_, 2 * DFF, F.G, (int)blockIdx.x);
        pg8::EpiSwiGLU E{ACT, DFF};
        pg8::gemm_phase<pg8::EpiSwiGLU, pg8::StaticOrder, true, true>(F.lds + RING_OFF, g, So, E);
        if (PROBE_REP & 2) pg8::gemm_phase<pg8::EpiSwiGLU, pg8::StaticOrder, true, true>(F.lds + RING_OFF, g, So, E);
        tail_convert(F, L, part); }
    PH_END();
    if (PH_ON()) { pg8::Gemm g{ACT, (const bf16*)(F.ws + WS_WFFN + (size_t)f * FFN_STRIDE + FFN_WD_OFF), S_, DM, DFF}; pg8::StaticOrder So; So.init(S_, DM, F.G, (int)blockIdx.x);
        if (first) { pg8::EpiResid<false, true> E{F.x_in, XS, DM, 0.5f}; pg8::gemm_phase<pg8::EpiResid<false, true>, pg8::StaticOrder, true, true>(F.lds + RING_OFF, g, So, E); }
        else if (last) { pg8::EpiResid<true, false> E{XS, F.out, DM, 0.5f}; pg8::gemm_phase<pg8::EpiResid<true, false>, pg8::StaticOrder, true, true>(F.lds + RING_OFF, g, So, E); }
        else { pg8::EpiResid<true, true> E{XS, XS, DM, 0.5f}; pg8::gemm_phase<pg8::EpiResid<true, true>, pg8::StaticOrder, true, true>(F.lds + RING_OFF, g, So, E); } }
    PH_END();
}
__device__ __forceinline__ void mla_block(Frame& F, Ctx& C, int L) {
    WS_PTRS();
    const float* gL = F.norm_g + (size_t)L * 3 * DM;
    const int j = L >> 1; unsigned char* wb = F.ws + WS_WMLA + (size_t)j * MLA_STRIDE;
    if (PH_ON()) p_norm<true>(F, XS, gL + DM, XN);
    PH_END();
    if (PH_ON()) { pg8::Gemm g{XN, (const bf16*)wb, S_, MLA_NA_PAD, DM}; pg8::StaticOrder So; So.init(S_, MLA_NA_PAD, F.G, (int)blockIdx.x);
        pg8::EpiMlaA E{CQN, CKVN, KPE, SSA};
        pg8::gemm_phase<pg8::EpiMlaA, pg8::StaticOrder, true, true>(F.lds + RING_OFF, g, So, E);
        tail_convert(F, L, 1); }
    PH_END();
    if (PH_ON()) {
        { pg8::Gemm g{CQN, (const bf16*)(wb + MLA_WUQ_OFF), S_, MLA_NQ, MLA_R}; pg8::StaticOrder So; So.init(S_, MLA_NQ, F.G, (int)blockIdx.x);
          build_rstd<8>(F, So, SSA, 16, 0, 1.0f / MLA_R);
          pg8::EpiBf16R E{Q, MLA_NQ, RSTAB};
          pg8::gemm_phase<pg8::EpiBf16R, pg8::StaticOrder, true, true>(F.lds + RING_OFF, g, So, E); }
        { pg8::Gemm g{CKVN, (const bf16*)(wb + MLA_WUKV_OFF), S_, MLA_NKV, MLA_R}; pg8::StaticOrder So; So.init(S_, MLA_NKV, F.G, (int)blockIdx.x);
          build_rstd<8>(F, So, SSA, 16, 8, 1.0f / MLA_R);
          pg8::EpiBf16R E{KV, MLA_NKV, RSTAB};
          pg8::gemm_phase<pg8::EpiBf16R, pg8::StaticOrder, true, true>(F.lds + RING_OFF, g, So, E); }
    }
    PH_END();
    if (PH_ON()) p_mla_prep(F, KV, KPE, F.mla_kg + j * 192, KN);
    PH_END();
    if (PH_ON()) {
        for (int u = F.vcu; u < 16 * 32; u += F.G) att::mla::MLA_UNIT<0>(F.lds + RING_OFF, (LAS float*)(F.lds + WSCR_OFF), Q, KN, KV, OB, u >> 5, u & 31, F.mla_qg + j * 192, (const float*)(F.ws + WS_COS), (const float*)(F.ws + WS_SIN));
        if (PROBE_REP & 4) for (int u = F.vcu; u < 16 * 32; u += F.G) att::mla::MLA_UNIT<PROBE_MODE>(F.lds + RING_OFF, (LAS float*)(F.lds + WSCR_OFF), Q, KN, KV, (bf16*)(F.ws + WS_END), u >> 5, u & 31, F.mla_qg + j * 192, (const float*)(F.ws + WS_COS), (const float*)(F.ws + WS_SIN));
    }
    PH_END();
    if (PH_ON()) { pg8::Gemm g{OB, (const bf16*)(wb + MLA_WO_OFF), S_, DM, DM}; pg8::StaticOrder So; So.init(S_, DM, F.G, (int)blockIdx.x);
        pg8::EpiResid<true, true> E{XS, XS, DM, 1.0f};
        pg8::gemm_phase<pg8::EpiResid<true, true>, pg8::StaticOrder, true, true>(F.lds + RING_OFF, g, So, E); }
    PH_END();
}
__device__ __forceinline__ void swa_block(Frame& F, Ctx& C, int L) {
    WS_PTRS();
    const float* gL = F.norm_g + (size_t)L * 3 * DM;
    const int j = L >> 1; unsigned char* wb = F.ws + WS_WSWA + (size_t)j * SWA_STRIDE;
    if (PH_ON()) p_norm<true>(F, XS, gL + DM, XN);
    PH_END();
    if (PH_ON()) { pg8::Gemm g{XN, (const bf16*)wb, S_, SWA_NQKV, DM}; pg8::StaticOrder So; So.init(S_, SWA_NQKV, F.G, (int)blockIdx.x);
        pg8::EpiBf16<0> E{Q, SWA_NQKV, nullptr, 0, 0, 1.f};
        pg8::gemm_phase<pg8::EpiBf16<0>, pg8::StaticOrder, true, true>(F.lds + RING_OFF, g, So, E);
        if (PROBE_REP & 2048) pg8::gemm_phase<pg8::EpiBf16<0>, pg8::StaticOrder, true, true>(F.lds + RING_OFF, g, So, E);
        tail_convert(F, L, 1); }
    PH_END();
    if (PH_ON()) {
        for (int rep = 0; rep < ((PROBE_REP & 16) ? 2 : 1); ++rep) for (int u = F.vcu; u < 8 * 32; u += F.G)
            att::swa::super_unit(F.lds + RING_OFF, (LAS float*)(F.lds + POSK_OFF), (LAS float*)(F.lds + WSCR_OFF), F.lds + RSTAB_OFF, Q, F.positions, F.swa_qg + j * 64, F.swa_kg + j * 64, F.swa_sink + j * 32, OB, u >> 5, u & 31);
    }
    PH_END();
    if (PH_ON()) { pg8::Gemm g{OB, (const bf16*)(wb + SWA_WO_OFF), S_, DM, DM}; pg8::StaticOrder So; So.init(S_, DM, F.G, (int)blockIdx.x);
        pg8::EpiResid<true, true> E{XS, XS, DM, 1.0f};
        pg8::gemm_phase<pg8::EpiResid<true, true>, pg8::StaticOrder, true, true>(F.lds + RING_OFF, g, So, E); }
    PH_END();
}

struct Args { const void* in[19]; float* out; unsigned char* ws; int ph_lo, ph_hi; };
__global__ void __launch_bounds__(NWAVES * 64, 2) mk_fwd(Args args) {
    extern __shared__ __attribute__((aligned(16))) unsigned char lds[];
    Frame F;
    F.lds = (LAS unsigned char*)lds;
    F.MISC = (volatile LAS unsigned*)(F.lds + MISC_OFF);
    F.tid = threadIdx.x; F.lane = F.tid & 63; F.wave = __builtin_amdgcn_readfirstlane(F.tid >> 6);
    F.G = gridDim.x; { const int bx = blockIdx.x; F.vcu = (F.G % 8 == 0) ? (bx % 8) * (F.G / 8) + bx / 8 : bx; }
    F.ws = args.ws; F.ctl = (gu32*)(args.ws + WS_CTL);
    F.x_in = (const float*)args.in[0]; F.positions = (const int*)args.in[1]; F.norm_g = (const float*)args.in[2];
    F.ffn_wg = (const float*)args.in[3]; F.ffn_wu = (const float*)args.in[4]; F.ffn_wd = (const float*)args.in[5];
    F.mla_wa = (const float*)args.in[6]; F.mla_qag = (const float*)args.in[7]; F.mla_kvag = (const float*)args.in[8]; F.mla_wuq = (const float*)args.in[9]; F.mla_wukv = (const float*)args.in[10];
    F.mla_qg = (const float*)args.in[11]; F.mla_kg = (const float*)args.in[12]; F.mla_wo = (const float*)args.in[13];
    F.swa_wqkv = (const float*)args.in[14]; F.swa_qg = (const float*)args.in[15]; F.swa_kg = (const float*)args.in[16]; F.swa_sink = (const float*)args.in[17]; F.swa_wo = (const float*)args.in[18];
    F.out = args.out;
    for (int u = F.tid; u < (LDS_BYTES - LDSCTL_OFF) / 4; u += NWAVES * 64) ((LAS unsigned*)(F.lds + LDSCTL_OFF))[u] = 0u;
    __syncthreads();
    Ctx C; C.pid = 0; C.lo = args.ph_lo; C.hi = args.ph_hi;
    C.bar.bar = (unsigned*)(F.ctl + CW_BAR); C.bar.x = 0; C.bar.st = nullptr;
    if (!MK_PER_PHASE) C.bar = xcd_barrier_post((unsigned*)(F.ctl + CW_BAR), F.MISC + 8);

    if (PH_ON()) { p_prologue(F); p_norm<false>(F, F.x_in, F.norm_g, (bf16*)(F.ws + WS_XN)); if (PROBE_REP & 1) p_prologue(F); if (PROBE_REP & 64) { for (int rep = 0; rep < 20; ++rep) xcd_barrier(C.bar); } }
    PH_END();
#if TEST_PROG == 0
#pragma unroll 1
    for (int lp = 0; lp < 2; ++lp) {
        ffn_block(F, C, 2 * lp, 0); mla_block(F, C, 2 * lp); ffn_block(F, C, 2 * lp, 2);
        ffn_block(F, C, 2 * lp + 1, 0); swa_block(F, C, 2 * lp + 1); ffn_block(F, C, 2 * lp + 1, 2);
    }
#elif TEST_PROG == 6
    ffn_block(F, C, 0, 0); mla_block(F, C, 0); ffn_block(F, C, 0, 2);
    ffn_block(F, C, 1, 0); swa_block(F, C, 1); ffn_block(F, C, 1, 2);
    ffn_block(F, C, 2, 0); mla_block(F, C, 2); ffn_block(F, C, 2, 2);
    ffn_block(F, C, 3, 0); swa_block(F, C, 3); ffn_block(F, C, 3, 2);
#elif TEST_PROG == 1
    ffn_block(F, C, 0, 0);
#elif TEST_PROG == 2
    ffn_block(F, C, 0, 0); ffn_block(F, C, 0, 2);
#elif TEST_PROG == 3
    mla_block(F, C, 0);
#elif TEST_PROG == 4
    swa_block(F, C, 1);
#elif TEST_PROG == 5
    for (int lp = 0; lp < 2; ++lp) { ffn_block(F, C, 2 * lp, 0); }
#endif
}
#undef PH_ON
#undef PH_END
#undef WS_PTRS
constexpr int N_PHASES = 1 + 8 * 3 - 1 + 2 * 6 + 2 * 4;

extern "C" void kernel_launch(void* const* d_in, const int* in_sizes, int n_in, void* d_out, int out_size, void* d_ws, size_t ws_size, hipStream_t stream) {
    static int grid = 0;
    if (grid == 0) {
        if (n_in != 19 || in_sizes[0] != S_ * DM || out_size != S_ * DM || ws_size < WS_END) { fprintf(stderr, "kernel_launch: shape mismatch (n_in %d, in0 %d, out %d, ws %zu < %zu)\n", n_in, n_in > 0 ? in_sizes[0] : -1, out_size, ws_size, (size_t)WS_END); grid = -1; return; }
        int dev = 0, cus = 0, per_cu = 0;
        if (hipGetDevice(&dev) != hipSuccess || hipDeviceGetAttribute(&cus, hipDeviceAttributeMultiprocessorCount, dev) != hipSuccess) { fprintf(stderr, "kernel_launch: device query failed\n"); grid = -1; return; }
        if (hipFuncSetAttribute((const void*)mk_fwd, hipFuncAttributeMaxDynamicSharedMemorySize, LDS_BYTES) != hipSuccess) { fprintf(stderr, "kernel_launch: hipFuncSetAttribute failed\n"); grid = -1; return; }
        if (hipOccupancyMaxActiveBlocksPerMultiprocessor(&per_cu, (const void*)mk_fwd, NWAVES * 64, LDS_BYTES) != hipSuccess || per_cu < 1)
            fprintf(stderr, "kernel_launch: note: occupancy query reports %d workgroups per CU\n", per_cu);
        (void)hipGetLastError();
        grid = cus;
    }
    if (grid < 0) return;
    if (hipMemsetAsync((char*)d_ws + WS_CTL, 0, CTL_USED_BYTES, stream) != hipSuccess) { fprintf(stderr, "kernel_launch: memset failed\n"); return; }
    Args a{};
    for (int i = 0; i < 19; ++i) a.in[i] = d_in[i];
    a.out = (float*)d_out; a.ws = (unsigned char*)d_ws;
#if MK_PER_PHASE
    for (int p = 0; p < N_PHASES; ++p) { a.ph_lo = p; a.ph_hi = p + 1; hipLaunchKernelGGL(mk_fwd, dim3(grid), dim3(NWAVES * 64), LDS_BYTES, stream, a); }
#else
    a.ph_lo = 0; a.ph_hi = N_PHASES;
    hipLaunchKernelGGL(mk_fwd, dim3(grid), dim3(NWAVES * 64), LDS_BYTES, stream, a);
#endif
    const hipError_t le = hipPeekAtLastError();
    if (le != hipSuccess) fprintf(stderr, "kernel_launch: launch failed: %s\n", hipGetErrorName(le));
}
```

```cpp
#include <hip/hip_runtime.h>
#include <cstdio>
#include <cstdint>
namespace pg8 {
#define PG8_LAS __attribute__((address_space(3)))
typedef unsigned short bf16_t;
typedef short bf16x8 __attribute__((ext_vector_type(8)));
typedef float f32x4 __attribute__((ext_vector_type(4)));
typedef unsigned u32x4 __attribute__((ext_vector_type(4)));
constexpr int BM = 256, BK = 64, HALF = 128, HTB = HALF * BK * 2  , STAGE_BYTES = 8 * HTB, NXCD = 8, WGM = 8;

__host__ __device__ __forceinline__ int lds_byte(int r, int c) { const int st = (r >> 4) * 2 + (c >> 5), rr = r & 15, cc = c & 31, ob = rr * 64 + cc * 2; return st * 1024 + (ob ^ (((ob >> 9) & 1) << 5)); }
__host__ __device__ __forceinline__ void stage_rc(int b, int& R, int& C) { const int st = b / 1024, sb = b % 1024, swz = sb ^ (((sb >> 9) & 1) << 5); R = (st >> 1) * 16 + swz / 64; C = (st & 1) * 32 + (swz % 64) / 2; }
__host__ __device__ __forceinline__ int perm32(int rho) { const int n = rho >> 4, i = rho & 15; return 8 * (i >> 2) + 4 * n + (i & 3); }

template <class T> __device__ __forceinline__ void st16(void* p, const T& v) { static_assert(sizeof(T) == 16, "st16"); *(T*)p = v; }
#define PG8_ST16(p, v) st16((void*)(p), (v))
struct Unit { int pm, pn; };
struct Gemm { const bf16_t* A; const bf16_t* Bt; int M, N, K; };

struct StaticOrder {
    int nM, nN, nwg, G, c;
    __host__ __device__ void init(int M, int N, int G_, int c_) { nM = M / BM; nN = N / BM; nwg = nM * nN; G = G_; c = c_; }
    __host__ __device__ bool next(int i, Unit& u) const {
        const long L = (long)i * G + c; if (L >= nwg) return false;
        int wgid = (int)L; { const int q = nwg / NXCD, r = nwg % NXCD, xcd = wgid % NXCD, off = wgid / NXCD; wgid = (xcd < r ? xcd * (q + 1) : r * (q + 1) + (xcd - r) * q) + off; }
        const int nig = WGM * nN, gid = wgid / nig, fm = gid * WGM, gsz = (nM - fm) < WGM ? (nM - fm) : WGM;
        u.pm = fm + ((wgid % nig) % gsz); u.pn = (wgid % nig) / gsz; return true;
    }
    __device__ __forceinline__ void a_ready(const Unit&) const {}
    __device__ __forceinline__ void done(const Unit&) const {}
};

__device__ __forceinline__ unsigned cvt_pk_bf16(float lo, float hi) { unsigned r; asm volatile("v_cvt_pk_bf16_f32 %0, %1, %2" : "=v"(r) : "v"(lo), "v"(hi)); return r; }
typedef float f32x2 __attribute__((ext_vector_type(2)));
__device__ __forceinline__ f32x2 gelu_pk(f32x2 v) {
    const f32x2 av = __builtin_elementwise_abs(v), d = av * 0.2316418882f + 1.0f;
    f32x2 t; t.x = __builtin_amdgcn_rcpf(d.x); t.y = __builtin_amdgcn_rcpf(d.y);
    f32x2 q = t * 0.5307027145f + (-0.7265760135f); q = q * t + 0.7107068705f; q = q * t + (-0.142248368f); q = q * t + 0.127414796f; q = q * t;
    const f32x2 s = (v * v) * (-0.72134752044f);
    f32x2 e; e.x = __builtin_amdgcn_exp2f(s.x); e.y = __builtin_amdgcn_exp2f(s.y);
    const f32x2 m = v * (q * e), r = v - m;
    f32x2 o; o.x = v.x < 0.f ? m.x : r.x; o.y = v.y < 0.f ? m.y : r.y; return o;
}

template <int ACT  > struct EpiBf16 {
    static constexpr bool PERM = true, AFTER_DRAIN = false; static_assert(ACT == 0 || ACT == 1, "EpiBf16: ACT is 0 (none) or 1 (gelu_pk)");
    bf16_t* O; int ldc; const float* bias; int split_cols; size_t split_stride; float scale0;
    __device__ __forceinline__ void operator()(const f32x4 (&acc)[2][2][4][2], const Unit& u, int wr, int wc, int fr, int fq) const {
        const int row0 = u.pm * BM + wr * 64 + fr; int colt = u.pn * BM; bf16_t* base = O;
        float sc = 1.f; if (split_cols) { const int t = colt / split_cols; base += (size_t)t * split_stride; colt -= t * split_cols; if (t == 0) sc = scale0; }
        const int col0 = colt + wc * 32 + 8 * fq, bcol0 = u.pn * BM + wc * 32 + 8 * fq;
        f32x4 bv[2][2];
#pragma unroll
        for (int bj = 0; bj < 2; ++bj)
#pragma unroll
            for (int n = 0; n < 2; ++n) bv[bj][n] = bias ? *(const f32x4*)(bias + bcol0 + bj * HALF + 4 * n) : (f32x4){0.f, 0.f, 0.f, 0.f};
#pragma unroll
        for (int ai = 0; ai < 2; ++ai)
#pragma unroll
            for (int m = 0; m < 4; ++m) { bf16_t* rowp = base + (size_t)(row0 + ai * HALF + m * 16) * ldc + col0;
#pragma unroll
                for (int bj = 0; bj < 2; ++bj) { f32x4 v0 = acc[ai][bj][m][0] + bv[bj][0], v1 = acc[ai][bj][m][1] + bv[bj][1];
                    if (ACT == 1) { f32x2 a = gelu_pk((f32x2){v0[0], v0[1]}), b = gelu_pk((f32x2){v0[2], v0[3]}), c = gelu_pk((f32x2){v1[0], v1[1]}), d = gelu_pk((f32x2){v1[2], v1[3]});
                        v0 = (f32x4){a.x, a.y, b.x, b.y}; v1 = (f32x4){c.x, c.y, d.x, d.y}; }
                    v0 = v0 * sc; v1 = v1 * sc; u32x4 w; w.x = cvt_pk_bf16(v0[0], v0[1]); w.y = cvt_pk_bf16(v0[2], v0[3]); w.z = cvt_pk_bf16(v1[0], v1[1]); w.w = cvt_pk_bf16(v1[2], v1[3]);
                    PG8_ST16(rowp + bj * HALF, w); } }
    }
};
struct EpiF32 {
    static constexpr bool PERM = false, AFTER_DRAIN = false;
    float* C; int ldc;
    __device__ __forceinline__ void operator()(const f32x4 (&acc)[2][2][4][2], const Unit& u, int wr, int wc, int fr, int fq) const {
        const int row0 = u.pm * BM + wr * 64 + fr, col0 = u.pn * BM + wc * 32 + 4 * fq;
#pragma unroll
        for (int ai = 0; ai < 2; ++ai)
#pragma unroll
            for (int m = 0; m < 4; ++m) { float* rowp = C + (size_t)(row0 + ai * HALF + m * 16) * ldc + col0;
#pragma unroll
                for (int bj = 0; bj < 2; ++bj)
#pragma unroll
                    for (int n = 0; n < 2; ++n) PG8_ST16(rowp + bj * HALF + n * 16, acc[ai][bj][m][n]); }
    }
};
typedef _Float16 f16x8_t __attribute__((ext_vector_type(8)));
template <bool RF, bool OF> struct EpiResid {
    static constexpr bool PERM = true, AFTER_DRAIN = false;
    const void* res; void* out; int ldc; float alpha;
    struct R8 { f32x4 a, b; };
    __device__ __forceinline__ static R8 ld8(const void* base, size_t off) { R8 r;
        if (RF) { const f16x8_t h = *(const f16x8_t*)((const _Float16*)base + off); r.a = (f32x4){(float)h[0], (float)h[1], (float)h[2], (float)h[3]}; r.b = (f32x4){(float)h[4], (float)h[5], (float)h[6], (float)h[7]}; }
        else { r.a = *(const f32x4*)((const float*)base + off); r.b = *(const f32x4*)((const float*)base + off + 4); }
        return r; }
    __device__ __forceinline__ static void st8(void* base, size_t off, const f32x4& a, const f32x4& b) {
        if (OF) { f16x8_t h = {(_Float16)a[0], (_Float16)a[1], (_Float16)a[2], (_Float16)a[3], (_Float16)b[0], (_Float16)b[1], (_Float16)b[2], (_Float16)b[3]}; *(f16x8_t*)((_Float16*)base + off) = h; }
        else { *(f32x4*)((float*)base + off) = a; *(f32x4*)((float*)base + off + 4) = b; } }
    __device__ __forceinline__ void operator()(const f32x4 (&acc)[2][2][4][2], const Unit& u, int wr, int wc, int fr, int fq) const {
        const int row0 = u.pm * BM + wr * 64 + fr, col0 = u.pn * BM + wc * 32 + 8 * fq;
        R8 cur[2], nxt[2];
        { const size_t off = (size_t)row0 * ldc + col0; cur[0] = ld8(res, off); cur[1] = ld8(res, off + HALF); }
#pragma unroll
        for (int gidx = 0; gidx < 8; ++gidx) { const int ai = gidx >> 2, m = gidx & 3;
            const size_t off = (size_t)(row0 + ai * HALF + m * 16) * ldc + col0;
            if (gidx < 7) { const int ai2 = (gidx + 1) >> 2, m2 = (gidx + 1) & 3; const size_t off2 = (size_t)(row0 + ai2 * HALF + m2 * 16) * ldc + col0;
                nxt[0] = ld8(res, off2); nxt[1] = ld8(res, off2 + HALF); }
#pragma unroll
            for (int bj = 0; bj < 2; ++bj) st8(out, off + bj * HALF, cur[bj].a + acc[ai][bj][m][0] * alpha, cur[bj].b + acc[ai][bj][m][1] * alpha);
            cur[0] = nxt[0]; cur[1] = nxt[1];
        }
    }
};
struct EpiSwiGLU {
    static constexpr bool PERM = true, AFTER_DRAIN = false;
    bf16_t* O; int ldc;
    __device__ __forceinline__ static float silu_mul(float g, float u) { const float e = __builtin_amdgcn_exp2f(g * -1.4426950408889634f); return g * u * __builtin_amdgcn_rcpf(1.0f + e); }
    __device__ __forceinline__ void operator()(const f32x4 (&acc)[2][2][4][2], const Unit& u, int wr, int wc, int fr, int fq) const {
        const int row0 = u.pm * BM + wr * 64 + fr, col0 = u.pn * HALF + wc * 32 + 8 * fq;
#pragma unroll
        for (int ai = 0; ai < 2; ++ai)
#pragma unroll
            for (int m = 0; m < 4; ++m) { bf16_t* rowp = O + (size_t)(row0 + ai * HALF + m * 16) * ldc + col0;
                const f32x4 g0 = acc[ai][0][m][0], g1 = acc[ai][0][m][1], u0 = acc[ai][1][m][0], u1 = acc[ai][1][m][1];
                u32x4 w; w.x = cvt_pk_bf16(silu_mul(g0[0], u0[0]), silu_mul(g0[1], u0[1])); w.y = cvt_pk_bf16(silu_mul(g0[2], u0[2]), silu_mul(g0[3], u0[3]));
                w.z = cvt_pk_bf16(silu_mul(g1[0], u1[0]), silu_mul(g1[1], u1[1])); w.w = cvt_pk_bf16(silu_mul(g1[2], u1[2]), silu_mul(g1[3], u1[3]));
                PG8_ST16(rowp, w); }
    }
};

constexpr float RMS_EPS_ = 1e-6f;
__device__ __forceinline__ void lds_rstd(float (&rs)[2][4], const PG8_LAS float* tab, const Unit& u, int wr, int fr) {
    const PG8_LAS float* p = tab + (u.pm & 7) * BM + wr * 64 + fr;
#pragma unroll
    for (int ai = 0; ai < 2; ++ai)
#pragma unroll
        for (int m = 0; m < 4; ++m) rs[ai][m] = p[ai * HALF + m * 16];
}
struct EpiBf16R {
    static constexpr bool PERM = true, AFTER_DRAIN = false;
    bf16_t* O; int ldc; const PG8_LAS float* rstab;
    __device__ __forceinline__ void operator()(const f32x4 (&acc)[2][2][4][2], const Unit& u, int wr, int wc, int fr, int fq) const {
        const int row0 = u.pm * BM + wr * 64 + fr, col0 = u.pn * BM + wc * 32 + 8 * fq;
        float rs[2][4]; lds_rstd(rs, rstab, u, wr, fr);
#pragma unroll
        for (int ai = 0; ai < 2; ++ai)
#pragma unroll
            for (int m = 0; m < 4; ++m) { bf16_t* rowp = O + (size_t)(row0 + ai * HALF + m * 16) * ldc + col0; const float r = rs[ai][m];
#pragma unroll
                for (int bj = 0; bj < 2; ++bj) { const f32x4 v0 = acc[ai][bj][m][0] * r, v1 = acc[ai][bj][m][1] * r;
                    u32x4 w; w.x = cvt_pk_bf16(v0[0], v0[1]); w.y = cvt_pk_bf16(v0[2], v0[3]); w.z = cvt_pk_bf16(v1[0], v1[1]); w.w = cvt_pk_bf16(v1[2], v1[3]);
                    *(u32x4*)(rowp + bj * HALF) = w; } }
    }
};
struct EpiMlaA {
    static constexpr bool PERM = true, AFTER_DRAIN = false;
    bf16_t* cq; bf16_t* ckv; float* kpe; float* ssa;
    __device__ __forceinline__ void operator()(const f32x4 (&acc)[2][2][4][2], const Unit& u, int wr, int wc, int fr, int fq) const {
        const int row0 = u.pm * BM + wr * 64 + fr, colw = wc * 32 + 8 * fq;
#pragma unroll
        for (int ai = 0; ai < 2; ++ai)
#pragma unroll
            for (int m = 0; m < 4; ++m) { const int row = row0 + ai * HALF + m * 16;
                if (u.pn < 4) { bf16_t* rowp = (u.pn < 2 ? cq : ckv) + (size_t)row * 512 + (u.pn & 1) * BM + colw; float sq = 0.f;
#pragma unroll
                    for (int bj = 0; bj < 2; ++bj) { const f32x4 v0 = acc[ai][bj][m][0], v1 = acc[ai][bj][m][1];
                        u32x4 w; w.x = cvt_pk_bf16(v0[0], v0[1]); w.y = cvt_pk_bf16(v0[2], v0[3]); w.z = cvt_pk_bf16(v1[0], v1[1]); w.w = cvt_pk_bf16(v1[2], v1[3]);
                        *(u32x4*)(rowp + bj * HALF) = w;
                        sq += ((v0[0] * v0[0] + v0[1] * v0[1]) + (v0[2] * v0[2] + v0[3] * v0[3])) + ((v1[0] * v1[0] + v1[1] * v1[1]) + (v1[2] * v1[2] + v1[3] * v1[3])); }
                    sq += __shfl_xor(sq, 16); sq += __shfl_xor(sq, 32);
                    if (fq == 0) ssa[(size_t)row * 16 + u.pn * 4 + wc] = sq; }
                else if (wc < 2) { float* rowp = kpe + (size_t)row * 64 + colw; *(f32x4*)rowp = acc[ai][0][m][0]; *(f32x4*)(rowp + 4) = acc[ai][0][m][1]; } }
    }
};
template <class Epi, class Sched, bool ALIGN_EPI = false, bool SP2 = false>
__device__ __forceinline__ void gemm_phase(PG8_LAS unsigned char* lds, const Gemm g, const Sched& S, const Epi& E) {
    const int tid = threadIdx.x, wid = __builtin_amdgcn_readfirstlane(tid >> 6), lane = tid & 63, wr = wid >> 2, wc = wid & 3, fr = lane & 15, fq = lane >> 4;
    const int K = g.K, nt = K / BK;
    unsigned voffA[2], voffB[2];
#pragma unroll
    for (int i = 0; i < 2; ++i) { int R, C; stage_rc(tid * 16 + i * 8192, R, C); const int Rb = Epi::PERM ? ((R & ~31) + perm32(R & 31)) : R;
        voffA[i] = (unsigned)(R * K + C) * 2u; voffB[i] = (unsigned)(Rb * K + C) * 2u; }
    const size_t kstep = (size_t)(BK * 2);
    const size_t hstep = (size_t)HALF * K * 2;
    const size_t tstep = 2 * hstep;
    const unsigned ldsw = (unsigned)wid * 1024u;
    const int aoff = lds_byte(wr * 64 + fr, fq * 8), boff = lds_byte(wc * 32 + fr, fq * 8);
#define PG8_SA(b, h) (((b) * 2 + (h)) * HTB)
#define PG8_SB(b, h) ((4 + (b) * 2 + (h)) * HTB)
#define PG8_STAGE(bufoff, gbase, voff) do { _Pragma("unroll") for (int _i = 0; _i < 2; ++_i) \
        __builtin_amdgcn_global_load_lds((const unsigned*)((const char*)(gbase) + (voff)[_i]), (PG8_LAS unsigned*)(lds + (bufoff) + ldsw + _i * 8192), 16, 0, 0); } while (0)
#define PG8_LDA(dst, b, h) do { _Pragma("unroll") for (int m = 0; m < 4; ++m) _Pragma("unroll") for (int k = 0; k < 2; ++k) dst[m][k] = *(const PG8_LAS bf16x8*)(lds + PG8_SA(b, h) + aoff + m * 2048 + k * 1024); } while (0)
#define PG8_LDB(dst, b, h) do { _Pragma("unroll") for (int n = 0; n < 2; ++n) _Pragma("unroll") for (int k = 0; k < 2; ++k) dst[n][k] = *(const PG8_LAS bf16x8*)(lds + PG8_SB(b, h) + boff + n * 2048 + k * 1024); } while (0)
#define PG8_MMA(ai, bj, At, Bt) do { __builtin_amdgcn_s_setprio(1); _Pragma("unroll") for (int m = 0; m < 4; ++m) _Pragma("unroll") for (int n = 0; n < 2; ++n) _Pragma("unroll") for (int k = 0; k < 2; ++k) \
        acc[ai][bj][m][n] = __builtin_amdgcn_mfma_f32_16x16x32_bf16(Bt[n][k], At[m][k], acc[ai][bj][m][n], 0, 0, 0); __builtin_amdgcn_s_setprio(0); } while (0)
#define PG8_WAIT_V(n) asm volatile("s_waitcnt vmcnt(" #n ")" ::: "memory")
#define PG8_WAIT_L(n) asm volatile("s_waitcnt lgkmcnt(" #n ")" ::: "memory")
#define PG8_BAR __builtin_amdgcn_s_barrier()
#define PG8_SCHED __builtin_amdgcn_sched_barrier(0)
    Unit cur, nxt; int ui = 0;
    if (!S.next(0, cur)) return;
    f32x4 acc[2][2][4][2];
#pragma unroll
    for (int a = 0; a < 2; ++a)
#pragma unroll
        for (int b = 0; b < 2; ++b)
#pragma unroll
            for (int m = 0; m < 4; ++m)
#pragma unroll
                for (int n = 0; n < 2; ++n) acc[a][b][m][n] = (f32x4){0.f, 0.f, 0.f, 0.f};
    bf16x8 At[4][2], B0[2][2], B1[2][2];
    const char* cA = (const char*)g.A + (size_t)cur.pm * tstep; const char* cB = (const char*)g.Bt + (size_t)cur.pn * tstep;
    S.a_ready(cur);
    if constexpr (SP2) {
        PG8_STAGE(PG8_SB(0, 0), cB, voffB); PG8_STAGE(PG8_SB(0, 1), cB + hstep, voffB); PG8_STAGE(PG8_SA(0, 0), cA, voffA); PG8_STAGE(PG8_SA(0, 1), cA + hstep, voffA);
        if (wr == 1) PG8_BAR;
        PG8_WAIT_V(2); PG8_BAR;
        PG8_STAGE(PG8_SB(1, 0), cB + kstep, voffB); PG8_STAGE(PG8_SA(1, 0), cA + kstep, voffA); PG8_STAGE(PG8_SB(1, 1), cB + hstep + kstep, voffB);
        PG8_WAIT_V(6); PG8_BAR;
    } else {
        PG8_STAGE(PG8_SB(0, 0), cB, voffB); PG8_STAGE(PG8_SA(0, 0), cA, voffA); PG8_STAGE(PG8_SB(0, 1), cB + hstep, voffB); PG8_STAGE(PG8_SA(0, 1), cA + hstep, voffA);
        if (wr == 1) PG8_BAR;
        PG8_WAIT_V(4); PG8_BAR;
        PG8_STAGE(PG8_SB(1, 0), cB + kstep, voffB); PG8_STAGE(PG8_SA(1, 0), cA + kstep, voffA); PG8_STAGE(PG8_SB(1, 1), cB + hstep + kstep, voffB);
        PG8_WAIT_V(6); PG8_BAR;
    }
    for (;;) {
        const bool has_next = S.next(ui + 1, nxt);
        const char* nA = has_next ? (const char*)g.A + (size_t)nxt.pm * tstep : cA; const char* nB = has_next ? (const char*)g.Bt + (size_t)nxt.pn * tstep : cB;
        for (int t = 0; t < nt; t += 2) {
            const bool last = (t == nt - 2);
            const char* a1 = cA + (size_t)(t + 1) * kstep;
            const char* a2 = last ? nA : cA + (size_t)(t + 2) * kstep; const char* b2 = last ? nB : cB + (size_t)(t + 2) * kstep;
            const char* a3 = a2 + kstep; const char* b3 = b2 + kstep;
            if (last && has_next) S.a_ready(nxt);
            if constexpr (SP2) {
            PG8_LDB(B0, 0, 0); PG8_LDB(B1, 0, 1); PG8_SCHED; PG8_LDA(At, 0, 0); PG8_STAGE(PG8_SA(1, 1), a1 + hstep, voffA);
            PG8_WAIT_V(8); PG8_WAIT_L(0); PG8_BAR; PG8_MMA(0, 0, At, B0); PG8_MMA(0, 1, At, B1); PG8_BAR; PG8_SCHED;
            PG8_LDA(At, 0, 1); PG8_STAGE(PG8_SB(0, 0), b2, voffB); PG8_STAGE(PG8_SB(0, 1), b2 + hstep, voffB); PG8_STAGE(PG8_SA(0, 0), a2, voffA);
            PG8_WAIT_V(8); PG8_WAIT_L(0); PG8_BAR; PG8_MMA(1, 0, At, B0); PG8_MMA(1, 1, At, B1); PG8_BAR; PG8_SCHED;
            PG8_LDB(B0, 1, 0); PG8_LDB(B1, 1, 1); PG8_SCHED; PG8_LDA(At, 1, 0); PG8_STAGE(PG8_SA(0, 1), a2 + hstep, voffA);
            PG8_WAIT_V(8); PG8_WAIT_L(0); PG8_BAR; PG8_MMA(0, 0, At, B0); PG8_MMA(0, 1, At, B1); PG8_BAR; PG8_SCHED;
            PG8_LDA(At, 1, 1); PG8_STAGE(PG8_SB(1, 0), b3, voffB); PG8_STAGE(PG8_SB(1, 1), b3 + hstep, voffB); PG8_STAGE(PG8_SA(1, 0), a3, voffA);
            PG8_WAIT_V(8); PG8_WAIT_L(0); PG8_BAR; PG8_MMA(1, 0, At, B0); PG8_MMA(1, 1, At, B1); PG8_BAR; PG8_SCHED;
            } else {
            PG8_LDB(B0, 0, 0); PG8_SCHED; PG8_LDA(At, 0, 0); PG8_STAGE(PG8_SA(1, 1), a1 + hstep, voffA);
            PG8_WAIT_L(8); PG8_BAR; PG8_WAIT_L(0); PG8_MMA(0, 0, At, B0); PG8_BAR; PG8_SCHED;
            PG8_LDB(B1, 0, 1); PG8_STAGE(PG8_SB(0, 0), b2, voffB);
            PG8_BAR; PG8_WAIT_L(0); PG8_MMA(0, 1, At, B1); PG8_BAR;
            PG8_LDA(At, 0, 1); PG8_STAGE(PG8_SA(0, 0), a2, voffA);
            PG8_BAR; PG8_WAIT_L(0); PG8_MMA(1, 0, At, B0); PG8_BAR; PG8_SCHED;
            PG8_STAGE(PG8_SB(0, 1), b2 + hstep, voffB);
            PG8_WAIT_V(6); PG8_BAR; PG8_MMA(1, 1, At, B1); PG8_BAR;
            PG8_LDB(B0, 1, 0); PG8_SCHED; PG8_LDA(At, 1, 0); PG8_STAGE(PG8_SA(0, 1), a2 + hstep, voffA);
            PG8_WAIT_L(8); PG8_BAR; PG8_WAIT_L(0); PG8_MMA(0, 0, At, B0); PG8_BAR; PG8_SCHED;
            PG8_LDB(B1, 1, 1); PG8_STAGE(PG8_SB(1, 0), b3, voffB);
            PG8_BAR; PG8_WAIT_L(0); PG8_MMA(0, 1, At, B1); PG8_BAR;
            PG8_LDA(At, 1, 1); PG8_STAGE(PG8_SA(1, 0), a3, voffA);
            PG8_BAR; PG8_WAIT_L(0); PG8_MMA(1, 0, At, B0); PG8_BAR; PG8_SCHED;
            PG8_STAGE(PG8_SB(1, 1), b3 + hstep, voffB);
            PG8_WAIT_V(6); PG8_BAR; PG8_MMA(1, 1, At, B1); PG8_BAR;
            }
        }
        if constexpr (ALIGN_EPI) { if (wr == 0) PG8_BAR; }
        if constexpr (!Epi::AFTER_DRAIN) { E(acc, cur, wr, wc, fr, fq); S.done(cur); }
        if (!has_next) break;
#pragma unroll
        for (int a = 0; a < 2; ++a)
#pragma unroll
            for (int b = 0; b < 2; ++b)
#pragma unroll
                for (int m = 0; m < 4; ++m)
#pragma unroll
                    for (int n = 0; n < 2; ++n) acc[a][b][m][n] = (f32x4){0.f, 0.f, 0.f, 0.f};
        cur = nxt; cA = nA; cB = nB; ++ui;
        if constexpr (ALIGN_EPI) { if (wr == 1) PG8_BAR; }
    }
    PG8_WAIT_V(0);
    if constexpr (!ALIGN_EPI) { if (wr == 0) PG8_BAR; }
    PG8_BAR;
    if constexpr (Epi::AFTER_DRAIN) { E.fused(acc, cur, wr, wc, fr, fq, lds, wid, lane); S.done(cur); }
#undef PG8_SA
#undef PG8_SB
#undef PG8_STAGE
#undef PG8_LDA
#undef PG8_LDB
#undef PG8_MMA
#undef PG8_WAIT_V
#undef PG8_WAIT_L
#undef PG8_BAR
#undef PG8_SCHED
}
}
namespace att {
#define ATT_LAS __attribute__((address_space(3)))
typedef unsigned short bf16_t;
using bf16x8 = __attribute__((ext_vector_type(8))) short;
using s16x4  = __attribute__((ext_vector_type(4))) short;
using f32x16 = __attribute__((ext_vector_type(16))) float;
using f32x4  = __attribute__((ext_vector_type(4))) float;
using u32x4  = __attribute__((ext_vector_type(4))) unsigned;
#define ATT_SBAR() __builtin_amdgcn_sched_barrier(0)
#ifndef ATT_PRIO
#define ATT_PRIO 0
#endif
#ifndef SM_PK
#define SM_PK 0
#endif
constexpr float THR2 = 8.0f;
constexpr float LOG2E = 1.4426950408889634f;
__device__ __forceinline__ int crow(int r, int hi) { return (r & 3) + 8 * (r >> 2) + 4 * hi; }
__device__ __forceinline__ unsigned cvtpk(float lo, float hi) { unsigned r; asm volatile("v_cvt_pk_bf16_f32 %0, %1, %2" : "=v"(r) : "v"(lo), "v"(hi)); return r; }
__device__ __forceinline__ float bf2f(short x) { return __uint_as_float(((unsigned)(unsigned short)x) << 16); }
__device__ __forceinline__ void glds16(const void* gsrc, unsigned lds_dst) { unsigned keep;
  asm volatile("s_mov_b32 %0, m0\n\ts_mov_b32 m0, %2\n\ts_nop 0\n\tglobal_load_lds_dwordx4 %1, off\n\ts_mov_b32 m0, %0" : "=&s"(keep) : "v"(gsrc), "s"(lds_dst) : "memory"); }
#define ATT_WAIT_BAR() asm volatile("s_waitcnt vmcnt(0) lgkmcnt(0)\n\ts_barrier" ::: "memory")

__device__ __forceinline__ void partialSM2(f32x16& p0, f32x16& p1, float& m_reg, float& alpha) {
  float pmax = p0[0];
#pragma unroll
  for (int r = 1; r < 16; ++r) pmax = fmaxf(pmax, p0[r]);
#pragma unroll
  for (int r = 0; r < 16; ++r) pmax = fmaxf(pmax, p1[r]);
  { auto rr = __builtin_amdgcn_permlane32_swap(__float_as_uint(pmax), __float_as_uint(pmax), false, false);
    pmax = fmaxf(__uint_as_float(rr[0]), __uint_as_float(rr[1])); }
  if (__builtin_expect(__all(pmax - m_reg <= THR2), 1)) { alpha = 1.f; }
  else { const float mn = fmaxf(m_reg, pmax); alpha = __builtin_amdgcn_exp2f(m_reg - mn); m_reg = mn; }
#if SM_PK
  { typedef float f32x2_ __attribute__((ext_vector_type(2))); f32x2_ nm = {-m_reg, -m_reg}; asm volatile("" : "+v"(nm));
#pragma unroll
    for (int r = 0; r < 16; r += 2) { f32x2_ a = {p0[r], p0[r + 1]}, b = {p1[r], p1[r + 1]}; a += nm; b += nm; p0[r] = a[0]; p0[r + 1] = a[1]; p1[r] = b[0]; p1[r + 1] = b[1]; } }
#else
#pragma unroll
  for (int r = 0; r < 16; ++r) { p0[r] -= m_reg; p1[r] -= m_reg; }
#endif
#pragma unroll
  for (int r = 0; r < 16; ++r) p0[r] = __builtin_amdgcn_exp2f(p0[r]);
}
__device__ __forceinline__ void partialSM2n(f32x16& p0, f32x16& p1, f32x16& negm, float& alpha) {
  float pmax = p0[0];
#pragma unroll
  for (int r = 1; r < 16; ++r) pmax = fmaxf(pmax, p0[r]);
#pragma unroll
  for (int r = 0; r < 16; ++r) pmax = fmaxf(pmax, p1[r]);
  { auto rr = __builtin_amdgcn_permlane32_swap(__float_as_uint(pmax), __float_as_uint(pmax), false, false);
    pmax = fmaxf(__uint_as_float(rr[0]), __uint_as_float(rr[1])); }
  if (__builtin_expect(__all(pmax <= THR2), 1)) { alpha = 1.f; }
  else { const float d = fmaxf(pmax, 0.f); alpha = __builtin_amdgcn_exp2f(-d); const float nm = negm[0] - d;
#pragma unroll
    for (int r = 0; r < 16; ++r) { p0[r] -= d; p1[r] -= d; negm[r] = nm; } }
#pragma unroll
  for (int r = 0; r < 16; ++r) p0[r] = __builtin_amdgcn_exp2f(p0[r]);
}
__device__ __forceinline__ void finishSM(f32x16& p0, f32x16& p1, float alpha, float& l_reg, bf16x8& pa0, bf16x8& pa1, bf16x8& pa2, bf16x8& pa3) {
#pragma unroll
  for (int r = 0; r < 16; ++r) p1[r] = __builtin_amdgcn_exp2f(p1[r]);
#if SM_PK
  float ps;
  { typedef float f32x2_ __attribute__((ext_vector_type(2))); f32x2_ a = {p0[0], p0[1]}, b = {p1[0], p1[1]};
#pragma unroll
    for (int r = 2; r < 16; r += 2) { a += (f32x2_){p0[r], p0[r + 1]}; b += (f32x2_){p1[r], p1[r + 1]}; }
    a += b; ps = a[0] + a[1]; }
#else
  float ps = 0;
#pragma unroll
  for (int r = 0; r < 16; ++r) ps += p0[r];
#pragma unroll
  for (int r = 0; r < 16; ++r) ps += p1[r];
#endif
  { auto rr = __builtin_amdgcn_permlane32_swap(__float_as_uint(ps), __float_as_uint(ps), false, false);
    ps = __uint_as_float(rr[0]) + __uint_as_float(rr[1]); }
  l_reg = l_reg * alpha + ps;
#define ATT_PK4(P, BASE, OUT) do { unsigned a0 = cvtpk(P[BASE + 0], P[BASE + 1]), a1 = cvtpk(P[BASE + 2], P[BASE + 3]);   \
    unsigned b0 = cvtpk(P[BASE + 4], P[BASE + 5]), b1 = cvtpk(P[BASE + 6], P[BASE + 7]);                              \
    auto r0 = __builtin_amdgcn_permlane32_swap(a0, b0, false, false); auto r1 = __builtin_amdgcn_permlane32_swap(a1, b1, false, false); \
    u32x4 w = {r0[0], r1[0], r0[1], r1[1]}; OUT = *reinterpret_cast<bf16x8*>(&w); } while (0)
  ATT_PK4(p0, 0, pa0); ATT_PK4(p0, 8, pa1); ATT_PK4(p1, 0, pa2); ATT_PK4(p1, 8, pa3);
#undef ATT_PK4
}
__device__ __forceinline__ void softmaxFixed(f32x16& p0, f32x16& p1, float& l_reg, bf16x8& pa0, bf16x8& pa1, bf16x8& pa2, bf16x8& pa3) {
#pragma unroll
  for (int r = 0; r < 16; ++r) p0[r] = __builtin_amdgcn_exp2f(p0[r]);
#pragma unroll
  for (int r = 0; r < 16; ++r) p1[r] = __builtin_amdgcn_exp2f(p1[r]);
  float ps = 0;
#pragma unroll
  for (int r = 0; r < 16; ++r) ps += p0[r];
#pragma unroll
  for (int r = 0; r < 16; ++r) ps += p1[r];
  { auto rr = __builtin_amdgcn_permlane32_swap(__float_as_uint(ps), __float_as_uint(ps), false, false);
    ps = __uint_as_float(rr[0]) + __uint_as_float(rr[1]); }
  l_reg += ps;
#define ATT_PK4(P, BASE, OUT) do { unsigned a0 = cvtpk(P[BASE + 0], P[BASE + 1]), a1 = cvtpk(P[BASE + 2], P[BASE + 3]);   \
    unsigned b0 = cvtpk(P[BASE + 4], P[BASE + 5]), b1 = cvtpk(P[BASE + 6], P[BASE + 7]);                              \
    auto r0 = __builtin_amdgcn_permlane32_swap(a0, b0, false, false); auto r1 = __builtin_amdgcn_permlane32_swap(a1, b1, false, false); \
    u32x4 w = {r0[0], r1[0], r0[1], r1[1]}; OUT = *reinterpret_cast<bf16x8*>(&w); } while (0)
  ATT_PK4(p0, 0, pa0); ATT_PK4(p0, 8, pa1); ATT_PK4(p1, 0, pa2); ATT_PK4(p1, 8, pa3);
#undef ATT_PK4
}
__device__ __forceinline__ int v_rd_base(int lane) { return ((lane & 3) << 3) | (((lane >> 2) & 3) << 6) | (((lane >> 4) & 1) << 5) | (((lane >> 5) & 1) << 8); }
template <int OFF> __device__ __forceinline__ s16x4 tr_read(int vb) {
  s16x4 r; asm volatile("ds_read_b64_tr_b16 %0, %1 offset:%2" : "=&v"(r) : "v"(vb), "i"(OFF) : "memory"); return r;
}
template <int NCB, int D0> __device__ __forceinline__ void pv_one(f32x16& od, int vb, bf16x8 pa0, bf16x8 pa1, bf16x8 pa2, bf16x8 pa3) {
  constexpr int KS = 1024 * NCB, HF = 512 * NCB;
  const s16x4 l0 = tr_read<D0 * 512 + 0 * KS>(vb), h0 = tr_read<D0 * 512 + 0 * KS + HF>(vb), l1 = tr_read<D0 * 512 + 1 * KS>(vb), h1 = tr_read<D0 * 512 + 1 * KS + HF>(vb);
  const s16x4 l2 = tr_read<D0 * 512 + 2 * KS>(vb), h2 = tr_read<D0 * 512 + 2 * KS + HF>(vb), l3 = tr_read<D0 * 512 + 3 * KS>(vb), h3 = tr_read<D0 * 512 + 3 * KS + HF>(vb);
  asm volatile("s_waitcnt lgkmcnt(0)" ::: "memory"); ATT_SBAR();
#define ATT_PK(L, H) (bf16x8){L[0], L[1], L[2], L[3], H[0], H[1], H[2], H[3]}
  od = __builtin_amdgcn_mfma_f32_32x32x16_bf16(pa0, ATT_PK(l0, h0), od, 0, 0, 0);
  od = __builtin_amdgcn_mfma_f32_32x32x16_bf16(pa1, ATT_PK(l1, h1), od, 0, 0, 0);
  od = __builtin_amdgcn_mfma_f32_32x32x16_bf16(pa2, ATT_PK(l2, h2), od, 0, 0, 0);
  od = __builtin_amdgcn_mfma_f32_32x32x16_bf16(pa3, ATT_PK(l3, h3), od, 0, 0, 0);
#undef ATT_PK
}
#define ATT_RESC(ND, a) do { if (__any((a) < 1.f)) { if (hi == 0) al_l[r32] = (a); asm volatile("s_waitcnt lgkmcnt(0)" ::: "memory"); \
    _Pragma("unroll") for (int d_ = 0; d_ < ND; ++d_) _Pragma("unroll") for (int r_ = 0; r_ < 16; ++r_) o[d_][r_] *= al_l[crow(r_, hi)]; } } while (0)

namespace mla {
constexpr int S = 8192, LDQ = 3072, LDK = 3072, LDV = 4096, LDO = 2048, NT = S / 64;
constexpr int KP = 400, KT = 64 * KP, VT = 16384, K_OFF0 = 0, K_OFF1 = KT, V_OFF0 = 2 * KT, V_OFF1 = 2 * KT + VT, LDS_END = 2 * KT + 2 * VT;
constexpr int OST_PITCH = 136;
static_assert(8 * 32 * OST_PITCH * 2 <= LDS_END, "O staging fits in the K/V region");
__device__ __forceinline__ void qkt(f32x16& p0, f32x16& p1, const ATT_LAS unsigned char* Ks, const bf16x8* qr, int r32, int hi) {
  p0 = f32x16{}; p1 = f32x16{};
  const ATT_LAS unsigned char* kb = Ks + r32 * KP + hi * 16;
#pragma unroll
  for (int d0 = 0; d0 < 12; ++d0) {
    const bf16x8 b0 = *reinterpret_cast<const ATT_LAS bf16x8*>(kb + d0 * 32);
    const bf16x8 b1 = *reinterpret_cast<const ATT_LAS bf16x8*>(kb + 32 * KP + d0 * 32);
    p0 = __builtin_amdgcn_mfma_f32_32x32x16_bf16(b0, qr[d0], p0, 0, 0, 0);
    p1 = __builtin_amdgcn_mfma_f32_32x32x16_bf16(b1, qr[d0], p1, 0, 0, 0); }
}
__device__ __forceinline__ void pv4(f32x16* o, int vb, bf16x8 pa0, bf16x8 pa1, bf16x8 pa2, bf16x8 pa3) {
  pv_one<4, 0>(o[0], vb, pa0, pa1, pa2, pa3); pv_one<4, 1>(o[1], vb, pa0, pa1, pa2, pa3); pv_one<4, 2>(o[2], vb, pa0, pa1, pa2, pa3); pv_one<4, 3>(o[3], vb, pa0, pa1, pa2, pa3);
}
typedef short v4i16_t __attribute__((ext_vector_type(4)));
__device__ __forceinline__ s16x4 vtr(const ATT_LAS unsigned char* p) { return __builtin_bit_cast(s16x4, __builtin_amdgcn_ds_read_tr16_b64_v4i16((ATT_LAS v4i16_t*)p)); }
template <bool PV> __device__ __forceinline__ void mfma_block(f32x16& p0, f32x16& p1, f32x16* o, const ATT_LAS unsigned char* Ks, const ATT_LAS unsigned char* Vp, const bf16x8* qr, const bf16x8* pa, int r32, int hi) {
  const ATT_LAS unsigned char* kb = Ks + r32 * KP + hi * 16;
  bf16x8 k0[3], k1[3]; s16x4 vl[6], vh[6];
#define MB_KLD(s) do { k0[(s) % 3] = *reinterpret_cast<const ATT_LAS bf16x8*>(kb + (s) * 32); k1[(s) % 3] = *reinterpret_cast<const ATT_LAS bf16x8*>(kb + 32 * KP + (s) * 32); } while (0)
#define MB_VLD(s) do { vl[(s) % 6] = vtr(Vp + ((s) >> 2) * 512 + ((s) & 3) * 4096); vh[(s) % 6] = vtr(Vp + ((s) >> 2) * 512 + ((s) & 3) * 4096 + 2048); } while (0)
  MB_KLD(0); MB_KLD(1);
  p0 = f32x16{}; p1 = f32x16{};
#pragma unroll
  for (int d0 = 0; d0 < 12; ++d0) {
    if (d0 + 2 < 12) MB_KLD(d0 + 2);
    if (PV && d0 >= 7) MB_VLD(d0 - 7);
    ATT_SBAR();
    p0 = __builtin_amdgcn_mfma_f32_32x32x16_bf16(k0[d0 % 3], qr[d0], p0, 0, 0, 0);
    p1 = __builtin_amdgcn_mfma_f32_32x32x16_bf16(k1[d0 % 3], qr[d0], p1, 0, 0, 0);
    ATT_SBAR();
  }
  if (PV) {
#pragma unroll
    for (int s = 0; s < 16; ++s) {
      if (s + 5 < 16) MB_VLD(s + 5);
      ATT_SBAR();
      const s16x4 L = vl[s % 6], H = vh[s % 6];
      o[s >> 2] = __builtin_amdgcn_mfma_f32_32x32x16_bf16(pa[s & 3], (bf16x8){L[0], L[1], L[2], L[3], H[0], H[1], H[2], H[3]}, o[s >> 2], 0, 0, 0);
      ATT_SBAR();
    }
  }
#undef MB_KLD
#undef MB_VLD
}
template <bool PV> __device__ __forceinline__ void mfma_block_n(f32x16& p0, f32x16& p1, f32x16* o, const ATT_LAS unsigned char* Ks, const ATT_LAS unsigned char* Vp, const bf16x8* qr, const bf16x8* pa, int r32, int hi, const f32x16& cinit) {
  const ATT_LAS unsigned char* kb = Ks + r32 * KP + hi * 16;
  bf16x8 k0[3], k1[3]; s16x4 vl[6], vh[6];
#define MB_KLD(s) do { k0[(s) % 3] = *reinterpret_cast<const ATT_LAS bf16x8*>(kb + (s) * 32); k1[(s) % 3] = *reinterpret_cast<const ATT_LAS bf16x8*>(kb + 32 * KP + (s) * 32); } while (0)
#define MB_VLD(s) do { vl[(s) % 6] = vtr(Vp + ((s) >> 2) * 512 + ((s) & 3) * 4096); vh[(s) % 6] = vtr(Vp + ((s) >> 2) * 512 + ((s) & 3) * 4096 + 2048); } while (0)
  MB_KLD(0); MB_KLD(1);
#pragma unroll
  for (int d0 = 0; d0 < 12; ++d0) {
    if (d0 + 2 < 12) MB_KLD(d0 + 2);
    if (PV && d0 >= 7) MB_VLD(d0 - 7);
    ATT_SBAR();
    p0 = __builtin_amdgcn_mfma_f32_32x32x16_bf16(k0[d0 % 3], qr[d0], d0 == 0 ? cinit : p0, 0, 0, 0);
    p1 = __builtin_amdgcn_mfma_f32_32x32x16_bf16(k1[d0 % 3], qr[d0], d0 == 0 ? cinit : p1, 0, 0, 0);
    ATT_SBAR();
  }
  if (PV) {
#pragma unroll
    for (int s = 0; s < 16; ++s) {
      if (s + 5 < 16) MB_VLD(s + 5);
      ATT_SBAR();
      const s16x4 L = vl[s % 6], H = vh[s % 6];
      o[s >> 2] = __builtin_amdgcn_mfma_f32_32x32x16_bf16(pa[s & 3], (bf16x8){L[0], L[1], L[2], L[3], H[0], H[1], H[2], H[3]}, o[s >> 2], 0, 0, 0);
      ATT_SBAR();
    }
  }
#undef MB_KLD
#undef MB_VLD
}
#define ATT_BAR() asm volatile("s_barrier" ::: "memory")
template <int MODE> __device__ __forceinline__ void unit_stag(ATT_LAS unsigned char* lds, ATT_LAS float* wscr, const bf16_t* __restrict__ Qn, const bf16_t* __restrict__ Kn, const bf16_t* __restrict__ KV, bf16_t* __restrict__ O, int h, int qb,
                                                                const float* __restrict__ qg, const float* __restrict__ COS, const float* __restrict__ SIN) {
  const int tid = threadIdx.x, lane = tid & 63, r32 = lane & 31, hi = lane >> 5; const int wid = __builtin_amdgcn_readfirstlane(tid >> 6); const int half = wid >> 2;
  const unsigned lds0 = (unsigned)(uintptr_t)lds;
  ATT_LAS float* al_l = wscr + wid * 64; ATT_LAS float* li_l = al_l + 32;
  const bf16_t* Kh = Kn + h * 192; const bf16_t* Vh = KV + h * 256 + 128;
  int koff[4], voff[2];
#pragma unroll
  for (int i = 0; i < 4; ++i) { const int p = (wid + 8 * i) * 64 + lane, row = p / 25, c = p % 25; koff[i] = row * LDK + (c < 24 ? c : 23) * 8; }
#pragma unroll
  for (int i = 0; i < 2; ++i) { const int B = (wid + 8 * i) * 1024 + lane * 16, st = B >> 9, wi = B & 511, kk = (st >> 2) * 8 + (wi >> 6), c = (st & 3) * 32 + ((wi & 63) >> 1);
    const int k = (kk & ~0xC) | ((kk & 4) << 1) | ((kk & 8) >> 1); voff[i] = k * LDV + c; }
#define MLA_DMA_K(t, buf) do { if ((MODE & 2) && (t) > 1) break; const bf16_t* kt_ = Kh + (size_t)(t) * 64 * LDK; const unsigned b_ = lds0 + (unsigned)(buf); \
    glds16(kt_ + koff[0], b_ + (unsigned)wid * 1024u); glds16(kt_ + koff[1], b_ + (unsigned)(wid + 8) * 1024u); glds16(kt_ + koff[2], b_ + (unsigned)(wid + 16) * 1024u); \
    if (wid == 0) glds16(kt_ + koff[3], b_ + 24u * 1024u); } while (0)
#define MLA_DMA_V(t, buf) do { if ((MODE & 2) && (t) > 1) break; const bf16_t* vt_ = Vh + (size_t)(t) * 64 * LDV; const unsigned b_ = lds0 + (unsigned)(buf); \
    glds16(vt_ + voff[0], b_ + (unsigned)wid * 1024u); glds16(vt_ + voff[1], b_ + (unsigned)(wid + 8) * 1024u); } while (0)
  MLA_DMA_K(0, K_OFF0);
  bf16x8 qr[12];
  { const int tok = qb * 256 + wid * 32 + r32; const bf16_t* Qw = Qn + (size_t)tok * LDQ + h * 192 + hi * 8; float ss = 0.f;
#pragma unroll
    for (int d0 = 0; d0 < 12; ++d0) { qr[d0] = *reinterpret_cast<const bf16x8*>(Qw + d0 * 16);
#pragma unroll
      for (int e = 0; e < 8; ++e) { const float f = bf2f(qr[d0][e]); ss += f * f; } }
    { auto rr = __builtin_amdgcn_permlane32_swap(__float_as_uint(ss), __float_as_uint(ss), false, false); ss = __uint_as_float(rr[0]) + __uint_as_float(rr[1]); }
    const float rq = (LOG2E * 0.07216878364870322f) / sqrtf(ss * (1.0f / 192.0f) + 1e-6f);
#pragma unroll
    for (int d0 = 0; d0 < 8; ++d0) { const f32x4 ga = *(const f32x4*)(qg + d0 * 16 + hi * 8), gb = *(const f32x4*)(qg + d0 * 16 + hi * 8 + 4);
      u32x4 w; w.x = cvtpk(bf2f(qr[d0][0]) * rq * ga[0], bf2f(qr[d0][1]) * rq * ga[1]); w.y = cvtpk(bf2f(qr[d0][2]) * rq * ga[2], bf2f(qr[d0][3]) * rq * ga[3]);
      w.z = cvtpk(bf2f(qr[d0][4]) * rq * gb[0], bf2f(qr[d0][5]) * rq * gb[1]); w.w = cvtpk(bf2f(qr[d0][6]) * rq * gb[2], bf2f(qr[d0][7]) * rq * gb[3]);
      qr[d0] = *reinterpret_cast<bf16x8*>(&w); }
#pragma unroll
    for (int d0 = 8; d0 < 10; ++d0) { const int jj = (d0 - 8) * 16 + hi * 8;
      const f32x4 gxa = *(const f32x4*)(qg + 128 + jj), gxb = *(const f32x4*)(qg + 128 + jj + 4), gya = *(const f32x4*)(qg + 160 + jj), gyb = *(const f32x4*)(qg + 160 + jj + 4);
      const f32x4 ca = *(const f32x4*)(COS + (size_t)tok * 32 + jj), cb = *(const f32x4*)(COS + (size_t)tok * 32 + jj + 4), sa = *(const f32x4*)(SIN + (size_t)tok * 32 + jj), sb = *(const f32x4*)(SIN + (size_t)tok * 32 + jj + 4);
      float xo[8], yo[8];
#pragma unroll
      for (int e = 0; e < 8; ++e) { const float gx = e < 4 ? gxa[e] : gxb[e - 4], gy = e < 4 ? gya[e] : gyb[e - 4], c = e < 4 ? ca[e] : cb[e - 4], s = e < 4 ? sa[e] : sb[e - 4];
        const float x = bf2f(qr[d0][e]) * rq * gx, y = bf2f(qr[d0 + 2][e]) * rq * gy; xo[e] = x * c - y * s; yo[e] = y * c + x * s; }
      u32x4 wx = {cvtpk(xo[0], xo[1]), cvtpk(xo[2], xo[3]), cvtpk(xo[4], xo[5]), cvtpk(xo[6], xo[7])}, wy = {cvtpk(yo[0], yo[1]), cvtpk(yo[2], yo[3]), cvtpk(yo[4], yo[5]), cvtpk(yo[6], yo[7])};
      qr[d0] = *reinterpret_cast<bf16x8*>(&wx); qr[d0 + 2] = *reinterpret_cast<bf16x8*>(&wy); }
  }
  float m_reg = -1e30f, l_reg = 0.f; f32x16 o[4] = {};
  f32x16 p0, p1; float al = 1.f; bf16x8 pa[4] = {};
  const int vbase = (int)(lds0 + V_OFF0) + v_rd_base(lane); const ATT_LAS unsigned char* vptr = lds + V_OFF0 + v_rd_base(lane);
  ATT_WAIT_BAR();
  if (half) { MLA_DMA_K(1, K_OFF1); MLA_DMA_V(0, V_OFF0); ATT_BAR(); }
  if (!half) { MLA_DMA_K(1, K_OFF1); MLA_DMA_V(0, V_OFF0); }
  __builtin_amdgcn_s_setprio(1);
  mfma_block<false>(p0, p1, o, lds + K_OFF0, vptr, qr, pa, r32, hi);
  __builtin_amdgcn_s_setprio(0);
  if (half) ATT_WAIT_BAR(); else ATT_BAR();
  if (half) { MLA_DMA_K(2, K_OFF0); MLA_DMA_V(1, V_OFF1); }
  partialSM2(p0, p1, m_reg, al);
  finishSM(p0, p1, al, l_reg, pa[0], pa[1], pa[2], pa[3]);
  if (half) ATT_BAR(); else ATT_WAIT_BAR();
#pragma unroll 1
  for (int j = 1; j < NT; ++j) {
    const int kb = (j & 1) * KT, vprev = ((j + 1) & 1) * VT;
    if (!half) { if (j + 1 < NT) MLA_DMA_K(j + 1, K_OFF0 + (KT - kb)); MLA_DMA_V(j, V_OFF0 + (VT - vprev)); }
    __builtin_amdgcn_s_setprio(1);
    mfma_block<true>(p0, p1, o, lds + K_OFF0 + kb, vptr + vprev, qr, pa, r32, hi);
    __builtin_amdgcn_s_setprio(0);
    if (half) ATT_WAIT_BAR(); else ATT_BAR();
    if (half) { if (j + 2 < NT) MLA_DMA_K(j + 2, K_OFF0 + kb); if (j + 1 < NT) MLA_DMA_V(j + 1, V_OFF0 + vprev); }
    if (!(MODE & 1)) { partialSM2(p0, p1, m_reg, al); ATT_RESC(4, al);
    finishSM(p0, p1, al, l_reg, pa[0], pa[1], pa[2], pa[3]); }
    else { asm volatile("" : "+v"(p0), "+v"(p1)); l_reg += p0[0] + p1[5]; }
    if (half) ATT_BAR(); else ATT_WAIT_BAR();
  }
  pv4(o, vbase + ((NT - 1) & 1) * VT, pa[0], pa[1], pa[2], pa[3]);
  if (!half) ATT_BAR();
  if (hi == 0) li_l[r32] = l_reg;
  ATT_WAIT_BAR();
  float rli[16];
#pragma unroll
  for (int r = 0; r < 16; ++r) rli[r] = __builtin_amdgcn_rcpf(li_l[crow(r, hi)]);
  ATT_LAS bf16_t* stg = (ATT_LAS bf16_t*)lds + wid * (32 * OST_PITCH);
#pragma unroll
  for (int r = 0; r < 16; ++r) { const int orow = crow(r, hi);
#pragma unroll
    for (int d0 = 0; d0 < 4; ++d0) { const unsigned w = cvtpk(o[d0][r] * rli[r], 0.f); stg[orow * OST_PITCH + d0 * 32 + r32] = (bf16_t)(w & 0xffffu); } }
  asm volatile("s_waitcnt lgkmcnt(0)" ::: "memory");
  bf16_t* Ow = O + (size_t)(qb * 256 + wid * 32) * LDO + h * 128;
#pragma unroll
  for (int i = 0; i < 8; ++i) { const int row = i * 4 + (lane >> 4), ch = lane & 15; const u32x4 v = *(const ATT_LAS u32x4*)(stg + row * OST_PITCH + ch * 8); *(u32x4*)(Ow + (size_t)row * LDO + ch * 8) = v; }
  ATT_WAIT_BAR();
#undef MLA_DMA_K
#undef MLA_DMA_V
}
template <int MODE> __device__ __forceinline__ void unit_soft(ATT_LAS unsigned char* lds, ATT_LAS float* wscr, const bf16_t* __restrict__ Qn, const bf16_t* __restrict__ Kn, const bf16_t* __restrict__ KV, bf16_t* __restrict__ O, int h, int qb,
                                                                const float* __restrict__ qg, const float* __restrict__ COS, const float* __restrict__ SIN) {
  const int tid = threadIdx.x, lane = tid & 63, r32 = lane & 31, hi = lane >> 5; const int wid = __builtin_amdgcn_readfirstlane(tid >> 6); const int half = wid >> 2;
  const unsigned lds0 = (unsigned)(uintptr_t)lds;
  ATT_LAS float* al_l = wscr + wid * 64; ATT_LAS float* li_l = al_l + 32;
  const bf16_t* Kh = Kn + h * 192; const bf16_t* Vh = KV + h * 256 + 128;
  int koff[4], voff[2];
#pragma unroll
  for (int i = 0; i < 4; ++i) { const int p = (wid + 8 * i) * 64 + lane, row = p / 25, c = p % 25; koff[i] = row * LDK + (c < 24 ? c : 23) * 8; }
#pragma unroll
  for (int i = 0; i < 2; ++i) { const int B = (wid + 8 * i) * 1024 + lane * 16, st = B >> 9, wi = B & 511, kk = (st >> 2) * 8 + (wi >> 6), c = (st & 3) * 32 + ((wi & 63) >> 1);
    const int k = (kk & ~0xC) | ((kk & 4) << 1) | ((kk & 8) >> 1); voff[i] = k * LDV + c; }
#define MLA_DMA_K(t, buf) do { if ((MODE & 2) && (t) > 1) break; const bf16_t* kt_ = Kh + (size_t)(t) * 64 * LDK; const unsigned b_ = lds0 + (unsigned)(buf); \
    glds16(kt_ + koff[0], b_ + (unsigned)wid * 1024u); glds16(kt_ + koff[1], b_ + (unsigned)(wid + 8) * 1024u); glds16(kt_ + koff[2], b_ + (unsigned)(wid + 16) * 1024u); \
    if (wid == 0) glds16(kt_ + koff[3], b_ + 24u * 1024u); } while (0)
#define MLA_DMA_V(t, buf) do { if ((MODE & 2) && (t) > 1) break; const bf16_t* vt_ = Vh + (size_t)(t) * 64 * LDV; const unsigned b_ = lds0 + (unsigned)(buf); \
    glds16(vt_ + voff[0], b_ + (unsigned)wid * 1024u); glds16(vt_ + voff[1], b_ + (unsigned)(wid + 8) * 1024u); } while (0)
  MLA_DMA_K(0, K_OFF0);
  bf16x8 qr[12];
  { const int tok = qb * 256 + wid * 32 + r32; const bf16_t* Qw = Qn + (size_t)tok * LDQ + h * 192 + hi * 8; float ss = 0.f;
#pragma unroll
    for (int d0 = 0; d0 < 12; ++d0) { qr[d0] = *reinterpret_cast<const bf16x8*>(Qw + d0 * 16);
#pragma unroll
      for (int e = 0; e < 8; ++e) { const float f = bf2f(qr[d0][e]); ss += f * f; } }
    { auto rr = __builtin_amdgcn_permlane32_swap(__float_as_uint(ss), __float_as_uint(ss), false, false); ss = __uint_as_float(rr[0]) + __uint_as_float(rr[1]); }
    const float rq = (LOG2E * 0.07216878364870322f) / sqrtf(ss * (1.0f / 192.0f) + 1e-6f);
#pragma unroll
    for (int d0 = 0; d0 < 8; ++d0) { const f32x4 ga = *(const f32x4*)(qg + d0 * 16 + hi * 8), gb = *(const f32x4*)(qg + d0 * 16 + hi * 8 + 4);
      u32x4 w; w.x = cvtpk(bf2f(qr[d0][0]) * rq * ga[0], bf2f(qr[d0][1]) * rq * ga[1]); w.y = cvtpk(bf2f(qr[d0][2]) * rq * ga[2], bf2f(qr[d0][3]) * rq * ga[3]);
      w.z = cvtpk(bf2f(qr[d0][4]) * rq * gb[0], bf2f(qr[d0][5]) * rq * gb[1]); w.w = cvtpk(bf2f(qr[d0][6]) * rq * gb[2], bf2f(qr[d0][7]) * rq * gb[3]);
      qr[d0] = *reinterpret_cast<bf16x8*>(&w); }
#pragma unroll
    for (int d0 = 8; d0 < 10; ++d0) { const int jj = (d0 - 8) * 16 + hi * 8;
      const f32x4 gxa = *(const f32x4*)(qg + 128 + jj), gxb = *(const f32x4*)(qg + 128 + jj + 4), gya = *(const f32x4*)(qg + 160 + jj), gyb = *(const f32x4*)(qg + 160 + jj + 4);
      const f32x4 ca = *(const f32x4*)(COS + (size_t)tok * 32 + jj), cb = *(const f32x4*)(COS + (size_t)tok * 32 + jj + 4), sa = *(const f32x4*)(SIN + (size_t)tok * 32 + jj), sb = *(const f32x4*)(SIN + (size_t)tok * 32 + jj + 4);
      float xo[8], yo[8];
#pragma unroll
      for (int e = 0; e < 8; ++e) { const float gx = e < 4 ? gxa[e] : gxb[e - 4], gy = e < 4 ? gya[e] : gyb[e - 4], c = e < 4 ? ca[e] : cb[e - 4], s = e < 4 ? sa[e] : sb[e - 4];
        const float x = bf2f(qr[d0][e]) * rq * gx, y = bf2f(qr[d0 + 2][e]) * rq * gy; xo[e] = x * c - y * s; yo[e] = y * c + x * s; }
      u32x4 wx = {cvtpk(xo[0], xo[1]), cvtpk(xo[2], xo[3]), cvtpk(xo[4], xo[5]), cvtpk(xo[6], xo[7])}, wy = {cvtpk(yo[0], yo[1]), cvtpk(yo[2], yo[3]), cvtpk(yo[4], yo[5]), cvtpk(yo[6], yo[7])};
      qr[d0] = *reinterpret_cast<bf16x8*>(&wx); qr[d0 + 2] = *reinterpret_cast<bf16x8*>(&wy); }
  }
  float m_reg = -1e30f, l_reg = 0.f; f32x16 o[4] = {};
  f32x16 p0, p1; float al = 1.f; bf16x8 pa[4] = {};
  const int vbase = (int)(lds0 + V_OFF0) + v_rd_base(lane); const ATT_LAS unsigned char* vptr = lds + V_OFF0 + v_rd_base(lane);
  ATT_WAIT_BAR();
  if (half) { MLA_DMA_K(1, K_OFF1); MLA_DMA_V(0, V_OFF0); ATT_BAR(); }
  if (!half) { MLA_DMA_K(1, K_OFF1); MLA_DMA_V(0, V_OFF0); }
  __builtin_amdgcn_s_setprio(1);
  mfma_block<false>(p0, p1, o, lds + K_OFF0, vptr, qr, pa, r32, hi);
  __builtin_amdgcn_s_setprio(0);
  if (half) ATT_WAIT_BAR(); else ATT_BAR();
  if (half) { MLA_DMA_K(2, K_OFF0); MLA_DMA_V(1, V_OFF1); }
  partialSM2(p0, p1, m_reg, al);
  finishSM(p0, p1, al, l_reg, pa[0], pa[1], pa[2], pa[3]);
  if (!half) ATT_WAIT_BAR();
#pragma unroll 1
  for (int j = 1; j < NT; ++j) {
    const int kb = (j & 1) * KT, vprev = ((j + 1) & 1) * VT;
    if (!half) { if (j + 1 < NT) MLA_DMA_K(j + 1, K_OFF0 + (KT - kb)); MLA_DMA_V(j, V_OFF0 + (VT - vprev)); }
    __builtin_amdgcn_s_setprio(1);
    mfma_block<true>(p0, p1, o, lds + K_OFF0 + kb, vptr + vprev, qr, pa, r32, hi);
    __builtin_amdgcn_s_setprio(0);
    if (half) ATT_WAIT_BAR();
    if (half) { if (j + 2 < NT) MLA_DMA_K(j + 2, K_OFF0 + kb); if (j + 1 < NT) MLA_DMA_V(j + 1, V_OFF0 + vprev); }
    if (!(MODE & 1)) { partialSM2(p0, p1, m_reg, al); ATT_RESC(4, al);
    finishSM(p0, p1, al, l_reg, pa[0], pa[1], pa[2], pa[3]); }
    else { asm volatile("" : "+v"(p0), "+v"(p1)); l_reg += p0[0] + p1[5]; }
    if (!half) ATT_WAIT_BAR();
  }
  pv4(o, vbase + ((NT - 1) & 1) * VT, pa[0], pa[1], pa[2], pa[3]);
  if (hi == 0) li_l[r32] = l_reg;
  ATT_WAIT_BAR();
  float rli[16];
#pragma unroll
  for (int r = 0; r < 16; ++r) rli[r] = __builtin_amdgcn_rcpf(li_l[crow(r, hi)]);
  ATT_LAS bf16_t* stg = (ATT_LAS bf16_t*)lds + wid * (32 * OST_PITCH);
#pragma unroll
  for (int r = 0; r < 16; ++r) { const int orow = crow(r, hi);
#pragma unroll
    for (int d0 = 0; d0 < 4; ++d0) { const unsigned w = cvtpk(o[d0][r] * rli[r], 0.f); stg[orow * OST_PITCH + d0 * 32 + r32] = (bf16_t)(w & 0xffffu); } }
  asm volatile("s_waitcnt lgkmcnt(0)" ::: "memory");
  bf16_t* Ow = O + (size_t)(qb * 256 + wid * 32) * LDO + h * 128;
#pragma unroll
  for (int i = 0; i < 8; ++i) { const int row = i * 4 + (lane >> 4), ch = lane & 15; const u32x4 v = *(const ATT_LAS u32x4*)(stg + row * OST_PITCH + ch * 8); *(u32x4*)(Ow + (size_t)row * LDO + ch * 8) = v; }
  ATT_WAIT_BAR();
#undef MLA_DMA_K
#undef MLA_DMA_V
}
template <int MODE> __device__ __forceinline__ void unit_softn(ATT_LAS unsigned char* lds, ATT_LAS float* wscr, const bf16_t* __restrict__ Qn, const bf16_t* __restrict__ Kn, const bf16_t* __restrict__ KV, bf16_t* __restrict__ O, int h, int qb,
                                                                const float* __restrict__ qg, const float* __restrict__ COS, const float* __restrict__ SIN) {
  int tid = threadIdx.x; asm volatile("" : "+v"(tid));
  const int lane = tid & 63, r32 = lane & 31, hi = lane >> 5; const int wid = __builtin_amdgcn_readfirstlane(tid >> 6); const int half = wid >> 2;
  const unsigned lds0 = (unsigned)(uintptr_t)lds;
  ATT_LAS float* al_l = wscr + wid * 64; ATT_LAS float* li_l = al_l + 32;
  const bf16_t* Kh = Kn + h * 192; const bf16_t* Vh = KV + h * 256 + 128;
  int koff[4], voff[2];
#pragma unroll
  for (int i = 0; i < 4; ++i) { const int p = (wid + 8 * i) * 64 + lane, row = p / 25, c = p % 25; koff[i] = row * LDK + (c < 24 ? c : 23) * 8; }
#pragma unroll
  for (int i = 0; i < 2; ++i) { const int B = (wid + 8 * i) * 1024 + lane * 16, st = B >> 9, wi = B & 511, kk = (st >> 2) * 8 + (wi >> 6), c = (st & 3) * 32 + ((wi & 63) >> 1);
    const int k = (kk & ~0xC) | ((kk & 4) << 1) | ((kk & 8) >> 1); voff[i] = k * LDV + c; }
#define MLA_DMA_K(t, buf) do { if ((MODE & 2) && (t) > 1) break; const bf16_t* kt_ = Kh + (size_t)(t) * 64 * LDK; const unsigned b_ = lds0 + (unsigned)(buf); \
    glds16(kt_ + koff[0], b_ + (unsigned)wid * 1024u); glds16(kt_ + koff[1], b_ + (unsigned)(wid + 8) * 1024u); glds16(kt_ + koff[2], b_ + (unsigned)(wid + 16) * 1024u); \
    if (wid == 0) glds16(kt_ + koff[3], b_ + 24u * 1024u); } while (0)
#define MLA_DMA_V(t, buf) do { if ((MODE & 2) && (t) > 1) break; const bf16_t* vt_ = Vh + (size_t)(t) * 64 * LDV; const unsigned b_ = lds0 + (unsigned)(buf); \
    glds16(vt_ + voff[0], b_ + (unsigned)wid * 1024u); glds16(vt_ + voff[1], b_ + (unsigned)(wid + 8) * 1024u); } while (0)
  MLA_DMA_K(0, K_OFF0);
  bf16x8 qr[12];
  { const int tok = qb * 256 + wid * 32 + r32; const bf16_t* Qw = Qn + (size_t)tok * LDQ + h * 192 + hi * 8; float ss = 0.f;
#pragma unroll
    for (int d0 = 0; d0 < 12; ++d0) { qr[d0] = *reinterpret_cast<const bf16x8*>(Qw + d0 * 16);
#pragma unroll
      for (int e = 0; e < 8; ++e) { const float f = bf2f(qr[d0][e]); ss += f * f; } }
    { auto rr = __builtin_amdgcn_permlane32_swap(__float_as_uint(ss), __float_as_uint(ss), false, false); ss = __uint_as_float(rr[0]) + __uint_as_float(rr[1]); }
    const float rq = (LOG2E * 0.07216878364870322f) / sqrtf(ss * (1.0f / 192.0f) + 1e-6f);
#pragma unroll
    for (int d0 = 0; d0 < 8; ++d0) { const f32x4 ga = *(const f32x4*)(qg + d0 * 16 + hi * 8), gb = *(const f32x4*)(qg + d0 * 16 + hi * 8 + 4);
      u32x4 w; w.x = cvtpk(bf2f(qr[d0][0]) * rq * ga[0], bf2f(qr[d0][1]) * rq * ga[1]); w.y = cvtpk(bf2f(qr[d0][2]) * rq * ga[2], bf2f(qr[d0][3]) * rq * ga[3]);
      w.z = cvtpk(bf2f(qr[d0][4]) * rq * gb[0], bf2f(qr[d0][5]) * rq * gb[1]); w.w = cvtpk(bf2f(qr[d0][6]) * rq * gb[2], bf2f(qr[d0][7]) * rq * gb[3]);
      qr[d0] = *reinterpret_cast<bf16x8*>(&w); }
#pragma unroll
    for (int d0 = 8; d0 < 10; ++d0) { const int jj = (d0 - 8) * 16 + hi * 8;
      const f32x4 gxa = *(const f32x4*)(qg + 128 + jj), gxb = *(const f32x4*)(qg + 128 + jj + 4), gya = *(const f32x4*)(qg + 160 + jj), gyb = *(const f32x4*)(qg + 160 + jj + 4);
      const f32x4 ca = *(const f32x4*)(COS + (size_t)tok * 32 + jj), cb = *(const f32x4*)(COS + (size_t)tok * 32 + jj + 4), sa = *(const f32x4*)(SIN + (size_t)tok * 32 + jj), sb = *(const f32x4*)(SIN + (size_t)tok * 32 + jj + 4);
      float xo[8], yo[8];
#pragma unroll
      for (int e = 0; e < 8; ++e) { const float gx = e < 4 ? gxa[e] : gxb[e - 4], gy = e < 4 ? gya[e] : gyb[e - 4], c = e < 4 ? ca[e] : cb[e - 4], s = e < 4 ? sa[e] : sb[e - 4];
        const float x = bf2f(qr[d0][e]) * rq * gx, y = bf2f(qr[d0 + 2][e]) * rq * gy; xo[e] = x * c - y * s; yo[e] = y * c + x * s; }
      u32x4 wx = {cvtpk(xo[0], xo[1]), cvtpk(xo[2], xo[3]), cvtpk(xo[4], xo[5]), cvtpk(xo[6], xo[7])}, wy = {cvtpk(yo[0], yo[1]), cvtpk(yo[2], yo[3]), cvtpk(yo[4], yo[5]), cvtpk(yo[6], yo[7])};
      qr[d0] = *reinterpret_cast<bf16x8*>(&wx); qr[d0 + 2] = *reinterpret_cast<bf16x8*>(&wy); }
  }
  float m_reg = -1e30f, l_reg = 0.f; f32x16 o[4] = {};
  f32x16 p0, p1; float al = 1.f; bf16x8 pa[4] = {};
  const int vbase = (int)(lds0 + V_OFF0) + v_rd_base(lane); const ATT_LAS unsigned char* vptr = lds + V_OFF0 + v_rd_base(lane);
  ATT_WAIT_BAR();
  if (ATT_PRIO == 2 && half) __builtin_amdgcn_s_setprio(1);
  if (half) { MLA_DMA_K(1, K_OFF1); MLA_DMA_V(0, V_OFF0); ATT_BAR(); }
  if (!half) { MLA_DMA_K(1, K_OFF1); MLA_DMA_V(0, V_OFF0); }
  if (ATT_PRIO == 1) __builtin_amdgcn_s_setprio(1);
  mfma_block<false>(p0, p1, o, lds + K_OFF0, vptr, qr, pa, r32, hi);
  if (ATT_PRIO == 1) __builtin_amdgcn_s_setprio(0);
  if (half) ATT_WAIT_BAR(); else ATT_BAR();
  if (half) { MLA_DMA_K(2, K_OFF0); MLA_DMA_V(1, V_OFF1); }
  partialSM2(p0, p1, m_reg, al);
  finishSM(p0, p1, al, l_reg, pa[0], pa[1], pa[2], pa[3]);
  if (!half) ATT_WAIT_BAR();
  f32x16 negm;
#pragma unroll
  for (int r = 0; r < 16; ++r) negm[r] = -m_reg;
#pragma unroll 1
  for (int j = 1; j < NT; ++j) {
    const int kb = (j & 1) * KT, vprev = ((j + 1) & 1) * VT;
    if (!half) { if (j + 1 < NT) MLA_DMA_K(j + 1, K_OFF0 + (KT - kb)); MLA_DMA_V(j, V_OFF0 + (VT - vprev)); }
    if (ATT_PRIO == 1) __builtin_amdgcn_s_setprio(1);
    mfma_block_n<true>(p0, p1, o, lds + K_OFF0 + kb, vptr + vprev, qr, pa, r32, hi, negm);
    if (ATT_PRIO == 1) __builtin_amdgcn_s_setprio(0);
    if (half) ATT_WAIT_BAR();
    if (half) { if (j + 2 < NT) MLA_DMA_K(j + 2, K_OFF0 + kb); if (j + 1 < NT) MLA_DMA_V(j + 1, V_OFF0 + vprev); }
    if (!(MODE & 1)) { partialSM2n(p0, p1, negm, al); ATT_RESC(4, al);
    finishSM(p0, p1, al, l_reg, pa[0], pa[1], pa[2], pa[3]); }
    else { asm volatile("" : "+v"(p0), "+v"(p1)); l_reg += p0[0] + p1[5]; }
    if (!half) ATT_WAIT_BAR();
  }
  pv4(o, vbase + ((NT - 1) & 1) * VT, pa[0], pa[1], pa[2], pa[3]);
  if (ATT_PRIO == 2) __builtin_amdgcn_s_setprio(0);
  if (hi == 0) li_l[r32] = l_reg;
  ATT_WAIT_BAR();
  float rli[16];
#pragma unroll
  for (int r = 0; r < 16; ++r) rli[r] = __builtin_amdgcn_rcpf(li_l[crow(r, hi)]);
  ATT_LAS bf16_t* stg = (ATT_LAS bf16_t*)lds + wid * (32 * OST_PITCH);
#pragma unroll
  for (int r = 0; r < 16; ++r) { const int orow = crow(r, hi);
#pragma unroll
    for (int d0 = 0; d0 < 4; ++d0) { const unsigned w = cvtpk(o[d0][r] * rli[r], 0.f); stg[orow * OST_PITCH + d0 * 32 + r32] = (bf16_t)(w & 0xffffu); } }
  asm volatile("s_waitcnt lgkmcnt(0)" ::: "memory");
  bf16_t* Ow = O + (size_t)(qb * 256 + wid * 32) * LDO + h * 128;
#pragma unroll
  for (int i = 0; i < 8; ++i) { const int row = i * 4 + (lane >> 4), ch = lane & 15; const u32x4 v = *(const ATT_LAS u32x4*)(stg + row * OST_PITCH + ch * 8); *(u32x4*)(Ow + (size_t)row * LDO + ch * 8) = v; }
  ATT_WAIT_BAR();
#undef MLA_DMA_K
#undef MLA_DMA_V
}
template <int MODE> __device__ __forceinline__ bool unit_fixed(ATT_LAS unsigned char* lds, ATT_LAS float* wscr, const bf16_t* __restrict__ Qn, const bf16_t* __restrict__ Kn, const bf16_t* __restrict__ KV, bf16_t* __restrict__ O, int h, int qb,
                                                                const float* __restrict__ qg, const float* __restrict__ COS, const float* __restrict__ SIN) {
  int tid = threadIdx.x; asm volatile("" : "+v"(tid));
  const int lane = tid & 63, r32 = lane & 31, hi = lane >> 5; const int wid = __builtin_amdgcn_readfirstlane(tid >> 6); const int half = wid >> 2;
  const unsigned lds0 = (unsigned)(uintptr_t)lds;
  ATT_LAS float* al_l = wscr + wid * 64; ATT_LAS float* li_l = al_l + 32;
  ATT_LAS float* ovf = wscr + 512;
  if (tid == 0) *ovf = 0.f;
  const bf16_t* Kh = Kn + h * 192; const bf16_t* Vh = KV + h * 256 + 128;
  int koff[4], voff[2];
#pragma unroll
  for (int i = 0; i < 4; ++i) { const int p = (wid + 8 * i) * 64 + lane, row = p / 25, c = p % 25; koff[i] = row * LDK + (c < 24 ? c : 23) * 8; }
#pragma unroll
  for (int i = 0; i < 2; ++i) { const int B = (wid + 8 * i) * 1024 + lane * 16, st = B >> 9, wi = B & 511, kk = (st >> 2) * 8 + (wi >> 6), c = (st & 3) * 32 + ((wi & 63) >> 1);
    const int k = (kk & ~0xC) | ((kk & 4) << 1) | ((kk & 8) >> 1); voff[i] = k * LDV + c; }
#define MLA_DMA_K(t, buf) do { if ((MODE & 2) && (t) > 1) break; const bf16_t* kt_ = Kh + (size_t)(t) * 64 * LDK; const unsigned b_ = lds0 + (unsigned)(buf); \
    glds16(kt_ + koff[0], b_ + (unsigned)wid * 1024u); glds16(kt_ + koff[1], b_ + (unsigned)(wid + 8) * 1024u); glds16(kt_ + koff[2], b_ + (unsigned)(wid + 16) * 1024u); \
    if (wid == 0) glds16(kt_ + koff[3], b_ + 24u * 1024u); } while (0)
#define MLA_DMA_V(t, buf) do { if ((MODE & 2) && (t) > 1) break; const bf16_t* vt_ = Vh + (size_t)(t) * 64 * LDV; const unsigned b_ = lds0 + (unsigned)(buf); \
    glds16(vt_ + voff[0], b_ + (unsigned)wid * 1024u); glds16(vt_ + voff[1], b_ + (unsigned)(wid + 8) * 1024u); } while (0)
  MLA_DMA_K(0, K_OFF0);
  bf16x8 qr[12];
  { const int tok = qb * 256 + wid * 32 + r32; const bf16_t* Qw = Qn + (size_t)tok * LDQ + h * 192 + hi * 8; float ss = 0.f;
#pragma unroll
    for (int d0 = 0; d0 < 12; ++d0) { qr[d0] = *reinterpret_cast<const bf16x8*>(Qw + d0 * 16);
#pragma unroll
      for (int e = 0; e < 8; ++e) { const float f = bf2f(qr[d0][e]); ss += f * f; } }
    { auto rr = __builtin_amdgcn_permlane32_swap(__float_as_uint(ss), __float_as_uint(ss), false, false); ss = __uint_as_float(rr[0]) + __uint_as_float(rr[1]); }
    const float rq = (LOG2E * 0.07216878364870322f) / sqrtf(ss * (1.0f / 192.0f) + 1e-6f);
#pragma unroll
    for (int d0 = 0; d0 < 8; ++d0) { const f32x4 ga = *(const f32x4*)(qg + d0 * 16 + hi * 8), gb = *(const f32x4*)(qg + d0 * 16 + hi * 8 + 4);
      u32x4 w; w.x = cvtpk(bf2f(qr[d0][0]) * rq * ga[0], bf2f(qr[d0][1]) * rq * ga[1]); w.y = cvtpk(bf2f(qr[d0][2]) * rq * ga[2], bf2f(qr[d0][3]) * rq * ga[3]);
      w.z = cvtpk(bf2f(qr[d0][4]) * rq * gb[0], bf2f(qr[d0][5]) * rq * gb[1]); w.w = cvtpk(bf2f(qr[d0][6]) * rq * gb[2], bf2f(qr[d0][7]) * rq * gb[3]);
      qr[d0] = *reinterpret_cast<bf16x8*>(&w); }
#pragma unroll
    for (int d0 = 8; d0 < 10; ++d0) { const int jj = (d0 - 8) * 16 + hi * 8;
      const f32x4 gxa = *(const f32x4*)(qg + 128 + jj), gxb = *(const f32x4*)(qg + 128 + jj + 4), gya = *(const f32x4*)(qg + 160 + jj), gyb = *(const f32x4*)(qg + 160 + jj + 4);
      const f32x4 ca = *(const f32x4*)(COS + (size_t)tok * 32 + jj), cb = *(const f32x4*)(COS + (size_t)tok * 32 + jj + 4), sa = *(const f32x4*)(SIN + (size_t)tok * 32 + jj), sb = *(const f32x4*)(SIN + (size_t)tok * 32 + jj + 4);
      float xo[8], yo[8];
#pragma unroll
      for (int e = 0; e < 8; ++e) { const float gx = e < 4 ? gxa[e] : gxb[e - 4], gy = e < 4 ? gya[e] : gyb[e - 4], c = e < 4 ? ca[e] : cb[e - 4], s = e < 4 ? sa[e] : sb[e - 4];
        const float x = bf2f(qr[d0][e]) * rq * gx, y = bf2f(qr[d0 + 2][e]) * rq * gy; xo[e] = x * c - y * s; yo[e] = y * c + x * s; }
      u32x4 wx = {cvtpk(xo[0], xo[1]), cvtpk(xo[2], xo[3]), cvtpk(xo[4], xo[5]), cvtpk(xo[6], xo[7])}, wy = {cvtpk(yo[0], yo[1]), cvtpk(yo[2], yo[3]), cvtpk(yo[4], yo[5]), cvtpk(yo[6], yo[7])};
      qr[d0] = *reinterpret_cast<bf16x8*>(&wx); qr[d0 + 2] = *reinterpret_cast<bf16x8*>(&wy); }
  }
  float m_reg = -1e30f, l_reg = 0.f; f32x16 o[4] = {};
  f32x16 p0, p1; float al = 1.f; bf16x8 pa[4] = {};
  const int vbase = (int)(lds0 + V_OFF0) + v_rd_base(lane); const ATT_LAS unsigned char* vptr = lds + V_OFF0 + v_rd_base(lane);
  ATT_WAIT_BAR();
  if (ATT_PRIO == 2 && half) __builtin_amdgcn_s_setprio(1);
  if (half) { MLA_DMA_K(1, K_OFF1); MLA_DMA_V(0, V_OFF0); ATT_BAR(); }
  if (!half) { MLA_DMA_K(1, K_OFF1); MLA_DMA_V(0, V_OFF0); }
  if (ATT_PRIO == 1) __builtin_amdgcn_s_setprio(1);
  mfma_block<false>(p0, p1, o, lds + K_OFF0, vptr, qr, pa, r32, hi);
  if (ATT_PRIO == 1) __builtin_amdgcn_s_setprio(0);
  if (half) ATT_WAIT_BAR(); else ATT_BAR();
  if (half) { MLA_DMA_K(2, K_OFF0); MLA_DMA_V(1, V_OFF1); }
  partialSM2(p0, p1, m_reg, al);
  finishSM(p0, p1, al, l_reg, pa[0], pa[1], pa[2], pa[3]);
  if (!half) ATT_WAIT_BAR();
  f32x16 negm;
#pragma unroll
  for (int r = 0; r < 16; ++r) negm[r] = -m_reg;
#pragma unroll 1
  for (int j = 1; j < NT; ++j) {
    const int kb = (j & 1) * KT, vprev = ((j + 1) & 1) * VT;
    if (!half) { if (j + 1 < NT) MLA_DMA_K(j + 1, K_OFF0 + (KT - kb)); MLA_DMA_V(j, V_OFF0 + (VT - vprev)); }
    if (ATT_PRIO == 1) __builtin_amdgcn_s_setprio(1);
    mfma_block_n<true>(p0, p1, o, lds + K_OFF0 + kb, vptr + vprev, qr, pa, r32, hi, negm);
    if (ATT_PRIO == 1) __builtin_amdgcn_s_setprio(0);
    if (half) ATT_WAIT_BAR();
    if (half) { if (j + 2 < NT) MLA_DMA_K(j + 2, K_OFF0 + kb); if (j + 1 < NT) MLA_DMA_V(j + 1, V_OFF0 + vprev); }
    softmaxFixed(p0, p1, l_reg, pa[0], pa[1], pa[2], pa[3]);
    if (!half) ATT_WAIT_BAR();
  }
  pv4(o, vbase + ((NT - 1) & 1) * VT, pa[0], pa[1], pa[2], pa[3]);
  if (ATT_PRIO == 2) __builtin_amdgcn_s_setprio(0);
  if (hi == 0) li_l[r32] = l_reg;
  if (!(l_reg < 1e30f)) *ovf = 1.f;
  ATT_WAIT_BAR();
  const bool ok = (*ovf == 0.f);
  if (ok) {
  float rli[16];
#pragma unroll
  for (int r = 0; r < 16; ++r) rli[r] = __builtin_amdgcn_rcpf(li_l[crow(r, hi)]);
  ATT_LAS bf16_t* stg = (ATT_LAS bf16_t*)lds + wid * (32 * OST_PITCH);
#pragma unroll
  for (int r = 0; r < 16; ++r) { const int orow = crow(r, hi);
#pragma unroll
    for (int d0 = 0; d0 < 4; ++d0) { const unsigned w = cvtpk(o[d0][r] * rli[r], 0.f); stg[orow * OST_PITCH + d0 * 32 + r32] = (bf16_t)(w & 0xffffu); } }
  asm volatile("s_waitcnt lgkmcnt(0)" ::: "memory");
  bf16_t* Ow = O + (size_t)(qb * 256 + wid * 32) * LDO + h * 128;
#pragma unroll
  for (int i = 0; i < 8; ++i) { const int row = i * 4 + (lane >> 4), ch = lane & 15; const u32x4 v = *(const ATT_LAS u32x4*)(stg + row * OST_PITCH + ch * 8); *(u32x4*)(Ow + (size_t)row * LDO + ch * 8) = v; }
  }
  ATT_WAIT_BAR();
  return ok;
#undef MLA_DMA_K
#undef MLA_DMA_V
}
}

namespace swa {
constexpr int S = 8192, LDQKV = 3072, LDO = 2048, NTILE = S / 64, KCOL = 2048, VCOL = 2560;
constexpr int K_OFF = 0, V_OFF = 65536, SLOT = 8192;
__device__ __forceinline__ void super_unit(ATT_LAS unsigned char* lds, ATT_LAS float* posk, ATT_LAS float* wscr, ATT_LAS unsigned char* ostage, const bf16_t* __restrict__ QKV, const int* __restrict__ positions,
                                           const float* __restrict__ qg, const float* __restrict__ kg, const float* __restrict__ sink, bf16_t* __restrict__ O, int kvh, int jb) {
  const int tid = threadIdx.x, lane = tid & 63, r32 = lane & 31, hi = lane >> 5; const int wid = __builtin_amdgcn_readfirstlane(tid >> 6);
  const unsigned lds0 = (unsigned)(uintptr_t)lds;
  ATT_LAS float* al_l = wscr + wid * 64; ATT_LAS float* li_l = al_l + 32;
  const int T0 = 4 * jb - 2;
  { const int T = T0 + wid;
    if (T >= 0 && T < NTILE) {
      const bf16_t* kbase = QKV + (size_t)T * 64 * LDQKV + KCOL + kvh * 64; const bf16_t* vbase = QKV + (size_t)T * 64 * LDQKV + VCOL + kvh * 64;
#pragma unroll
      for (int pc = 0; pc < 8; ++pc) {
        const int row = pc * 8 + (lane >> 3), c = (lane & 7) ^ (row & 7);
        glds16(kbase + (size_t)row * LDQKV + c * 8, lds0 + K_OFF + (unsigned)wid * SLOT + (unsigned)pc * 1024u);
        const int kk = pc * 8 + ((lane & 31) >> 2), vc = (lane >> 5) * 32 + (lane & 3) * 8, k = (kk & ~0xC) | ((kk & 4) << 1) | ((kk & 8) >> 1);
        glds16(vbase + (size_t)k * LDQKV + vc, lds0 + V_OFF + (unsigned)wid * SLOT + (unsigned)pc * 1024u);
      }
    }
    const int s = 64 * T0 + tid; posk[tid] = (s >= 0 && s < S) ? (float)positions[s] : 0.f;
  }
  ATT_WAIT_BAR();
  { const int T = T0 + wid;
    if (T >= 0 && T < NTILE) {
      ATT_LAS unsigned char* rowp = lds + K_OFF + wid * SLOT + lane * 128;
      bf16x8 v[8]; float ss = 0.f;
#pragma unroll
      for (int c = 0; c < 8; ++c) { v[c] = *reinterpret_cast<const ATT_LAS bf16x8*>(rowp + c * 16);
#pragma unroll
        for (int e = 0; e < 8; ++e) { const float f = bf2f(v[c][e]); ss += f * f; } }
      const float rs = __builtin_amdgcn_rsqf(ss * (1.0f / 64.0f) + 1e-6f);
#pragma unroll
      for (int c = 0; c < 8; ++c) { u32x4 w; w.x = cvtpk(bf2f(v[c][0]) * rs, bf2f(v[c][1]) * rs); w.y = cvtpk(bf2f(v[c][2]) * rs, bf2f(v[c][3]) * rs);
        w.z = cvtpk(bf2f(v[c][4]) * rs, bf2f(v[c][5]) * rs); w.w = cvtpk(bf2f(v[c][6]) * rs, bf2f(v[c][7]) * rs); *reinterpret_cast<ATT_LAS u32x4*>(rowp + c * 16) = w; }
    }
  }
  ATT_WAIT_BAR();
  const int g = wid >> 1, hq = 4 * kvh + g;
  const float slope2 = __builtin_amdgcn_exp2f(-0.25f * (float)(hq + 1)) * LOG2E, sink2 = sink[hq] * LOG2E;
  const int vrb = (int)(lds0 + V_OFF) + v_rd_base(lane);
#pragma unroll 1
  for (int sb = 0; sb < 4; ++sb) {
    const int tw = 256 * jb + 64 * sb + 32 * (wid & 1), t = tw + r32;
    bf16x8 qr[4];
    { const bf16_t* Qp = QKV + (size_t)t * LDQKV + hq * 64 + hi * 8; bf16x8 raw[4]; float ss = 0.f;
#pragma unroll
      for (int d0 = 0; d0 < 4; ++d0) { raw[d0] = *reinterpret_cast<const bf16x8*>(Qp + d0 * 16);
#pragma unroll
        for (int e = 0; e < 8; ++e) { const float f = bf2f(raw[d0][e]); ss += f * f; } }
      { auto rr = __builtin_amdgcn_permlane32_swap(__float_as_uint(ss), __float_as_uint(ss), false, false); ss = __uint_as_float(rr[0]) + __uint_as_float(rr[1]); }
      const float rs = __builtin_amdgcn_rsqf(ss * (1.0f / 64.0f) + 1e-6f) * (0.125f * LOG2E);
#pragma unroll
      for (int d0 = 0; d0 < 4; ++d0) { const int dd = d0 * 16 + hi * 8; const f32x4 ga = *(const f32x4*)(qg + dd), gb = *(const f32x4*)(qg + dd + 4), ka = *(const f32x4*)(kg + dd), kb = *(const f32x4*)(kg + dd + 4);
        u32x4 w; w.x = cvtpk(bf2f(raw[d0][0]) * rs * ga[0] * ka[0], bf2f(raw[d0][1]) * rs * ga[1] * ka[1]); w.y = cvtpk(bf2f(raw[d0][2]) * rs * ga[2] * ka[2], bf2f(raw[d0][3]) * rs * ga[3] * ka[3]);
        w.z = cvtpk(bf2f(raw[d0][4]) * rs * gb[0] * kb[0], bf2f(raw[d0][5]) * rs * gb[1] * kb[1]); w.w = cvtpk(bf2f(raw[d0][6]) * rs * gb[2] * kb[2], bf2f(raw[d0][7]) * rs * gb[3] * kb[3]);
        qr[d0] = *reinterpret_cast<bf16x8*>(&w); } }
    const float posq = (float)positions[t];
    float l_reg = 1.0f; f32x16 o[2] = {};
    f32x16 negm;
#pragma unroll
    for (int r = 0; r < 16; ++r) negm[r] = -sink2;
#pragma unroll 1
    for (int lt = sb; lt < sb + 5; ++lt) {
      const int T = T0 + lt; if (T < 0 || T >= NTILE) continue;
      f32x16 p0, p1;
      { const ATT_LAS unsigned char* kb = lds + K_OFF + lt * SLOT + r32 * 128; const int sw = (r32 & 7) << 4;
#pragma unroll
        for (int d0 = 0; d0 < 4; ++d0) { const int cb = (d0 * 32 + hi * 16) ^ sw;
          const bf16x8 b0 = *reinterpret_cast<const ATT_LAS bf16x8*>(kb + cb); const bf16x8 b1 = *reinterpret_cast<const ATT_LAS bf16x8*>(kb + 4096 + cb);
          p0 = __builtin_amdgcn_mfma_f32_32x32x16_bf16(b0, qr[d0], d0 == 0 ? negm : p0, 0, 0, 0); p1 = __builtin_amdgcn_mfma_f32_32x32x16_bf16(b1, qr[d0], d0 == 0 ? negm : p1, 0, 0, 0); } }
      if (64 * T - tw >= -97 && 64 * T - tw <= 65)
      { const ATT_LAS float* pk = posk + 64 * lt + 4 * hi;
#pragma unroll
        for (int q4 = 0; q4 < 4; ++q4) { const f32x4 k0 = *reinterpret_cast<const ATT_LAS f32x4*>(pk + 8 * q4), k1 = *reinterpret_cast<const ATT_LAS f32x4*>(pk + 32 + 8 * q4);
#pragma unroll
          for (int e = 0; e < 4; ++e) { const int r = 4 * q4 + e;
            const float s0 = p0[r] - slope2 * fabsf(posq - k0[e]), s1 = p1[r] - slope2 * fabsf(posq - k1[e]);
            p0[r] = s0; p1[r] = s1; } } }
      else
      { const int delta = 64 * T - t + 4 * hi; const ATT_LAS float* pk = posk + 64 * lt + 4 * hi;
#pragma unroll
        for (int q4 = 0; q4 < 4; ++q4) { const f32x4 k0 = *reinterpret_cast<const ATT_LAS f32x4*>(pk + 8 * q4), k1 = *reinterpret_cast<const ATT_LAS f32x4*>(pk + 32 + 8 * q4);
#pragma unroll
          for (int e = 0; e < 4; ++e) { const int r = 4 * q4 + e, rel0 = delta + 8 * q4 + e, rel1 = rel0 + 32;
            const float s0 = p0[r] - slope2 * fabsf(posq - k0[e]), s1 = p1[r] - slope2 * fabsf(posq - k1[e]);
            p0[r] = ((unsigned)(rel0 + 128) <= 256u) ? s0 : -1e30f; p1[r] = ((unsigned)(rel1 + 128) <= 256u) ? s1 : -1e30f; } } }
      float al; bf16x8 pa0, pa1, pa2, pa3;
      partialSM2n(p0, p1, negm, al); ATT_RESC(2, al);
      finishSM(p0, p1, al, l_reg, pa0, pa1, pa2, pa3); ATT_SBAR();
      pv_one<2, 0>(o[0], vrb + lt * SLOT, pa0, pa1, pa2, pa3); pv_one<2, 1>(o[1], vrb + lt * SLOT, pa0, pa1, pa2, pa3);
    }
    if (hi == 0) li_l[r32] = l_reg; asm volatile("s_waitcnt lgkmcnt(0)" ::: "memory");
    bf16_t* Ow = O + (size_t)tw * LDO + hq * 64;
    ATT_LAS bf16_t* stg = (ATT_LAS bf16_t*)(ostage + wid * 1024);
#pragma unroll
    for (int gq = 0; gq < 4; ++gq) {
#pragma unroll
      for (int e = 0; e < 4; ++e) { const int r = 4 * gq + e; const float rl = __builtin_amdgcn_rcpf(li_l[crow(r, hi)]);
#pragma unroll
        for (int d0 = 0; d0 < 2; ++d0) { const unsigned w = cvtpk(o[d0][r] * rl, 0.f); stg[(e + 4 * hi) * 64 + d0 * 32 + r32] = (bf16_t)(w & 0xffffu); } }
      asm volatile("s_waitcnt lgkmcnt(0)" ::: "memory");
      { const int row = lane >> 3, ch = lane & 7; const u32x4 v = *(const ATT_LAS u32x4*)(stg + row * 64 + ch * 8); *(u32x4*)(Ow + (size_t)(8 * gq + row) * LDO + ch * 8) = v; }
      asm volatile("s_waitcnt lgkmcnt(0)" ::: "memory");
    }
    asm volatile("s_waitcnt lgkmcnt(0)" ::: "memory");
  }
  ATT_WAIT_BAR();
}
}
}
constexpr int NWAVES = 8;
constexpr int S_ = 8192, DM = 2048, DFF = 5632, DEPTH = 4;
constexpr int MLA_NA = 1088, MLA_NA_PAD = 1280, MLA_NQ = 3072, MLA_NKV = 4096, MLA_R = 512;
constexpr int SWA_NQKV = 3072;
constexpr float RMS_EPS = 1e-6f;
#ifndef TEST_PROG
#define TEST_PROG 6
#endif
#ifndef MLA_UNIT
#define MLA_UNIT unit_softn
#endif
#ifndef FIXED_FORCE_FALLBACK
#define FIXED_FORCE_FALLBACK 0
#endif
#ifndef PROBE_MODE
#define PROBE_MODE 0
#endif
#ifndef PROBE_REP
#define PROBE_REP 0
#endif
#ifndef MK_PER_PHASE
#define MK_PER_PHASE 0
#endif

constexpr size_t MiB = 1u << 20;
constexpr size_t WS_CTL = 0, CTL_ZERO_BYTES = 1 * MiB;
constexpr size_t WS_COS = 1 * MiB, WS_SIN = 2 * MiB;
constexpr size_t WS_WFFN = 4 * MiB, FFN_STRIDE = 66 * MiB, FFN_WD_OFF = 44 * MiB;
constexpr size_t WS_WMLA = WS_WFFN + 8 * FFN_STRIDE, MLA_STRIDE = 20 * MiB, MLA_WUQ_OFF = 5 * MiB, MLA_WUKV_OFF = 8 * MiB, MLA_WO_OFF = 12 * MiB;
constexpr size_t WS_WSWA = WS_WMLA + 2 * MLA_STRIDE, SWA_STRIDE = 20 * MiB, SWA_WO_OFF = 12 * MiB;
constexpr size_t WS_XN = WS_WSWA + 2 * SWA_STRIDE;
constexpr size_t WS_ACT = WS_XN + 32 * MiB;
constexpr size_t WS_SSA = WS_ACT + 88 * MiB;
constexpr size_t WS_KPE = WS_SSA + 1 * MiB;
constexpr size_t WS_CQN = WS_KPE + 2 * MiB, WS_CKVN = WS_CQN + 8 * MiB;
constexpr size_t WS_Q = WS_CKVN + 8 * MiB;
constexpr size_t WS_KV = WS_Q + 48 * MiB;
constexpr size_t WS_KN = WS_KV + 64 * MiB;
constexpr size_t WS_O = WS_KN + 48 * MiB;
constexpr size_t WS_XS = WS_O + 32 * MiB;
constexpr size_t WS_END = WS_XS + 32 * MiB;
constexpr int CW_BAR = 4096;
constexpr size_t CTL_USED_BYTES = 32768;

constexpr int RING_OFF = 0, RING_BYTES = 131072;
constexpr int LDSCTL_OFF = RING_BYTES, MISC_OFF = LDSCTL_OFF + 320;
constexpr int POSK_OFF = RING_BYTES + 1024;
constexpr int WSCR_OFF = RING_BYTES + 4096;
constexpr int RSTAB_OFF = RING_BYTES + 8192;
constexpr int LDS_BYTES = 147456;
static_assert(att::mla::LDS_END <= RING_BYTES && WSCR_OFF + 8 * 256 <= LDS_BYTES && MISC_OFF + 128 <= POSK_OFF && WSCR_OFF + 8 * 256 <= RSTAB_OFF && RSTAB_OFF + 8192 <= LDS_BYTES, "LDS map");

#define GAS __attribute__((address_space(1)))
#define LAS __attribute__((address_space(3)))
typedef unsigned short bf16;
typedef unsigned v4u __attribute__((ext_vector_type(4)));
typedef float f32x4 __attribute__((ext_vector_type(4)));
typedef short bf16x8 __attribute__((ext_vector_type(8)));
typedef GAS unsigned gu32;
typedef GAS unsigned long long gu64;
#define RLX_AGENT __ATOMIC_RELAXED, __HIP_MEMORY_SCOPE_AGENT
#define LDS_WAIT() asm volatile("s_waitcnt lgkmcnt(0)" ::: "memory")
#define VM_WAIT() asm volatile("s_waitcnt vmcnt(0)" ::: "memory")
__device__ __forceinline__ unsigned long long rt() { return __builtin_amdgcn_s_memrealtime(); }
__device__ __forceinline__ unsigned f2bf(float f) { unsigned u = __builtin_bit_cast(unsigned, f); return (u + 0x7fffu + ((u >> 16) & 1u)) >> 16; }
__device__ __forceinline__ unsigned pk2(float lo, float hi) { return f2bf(lo) | (f2bf(hi) << 16); }

#define XB_TMO      128
#define XB_XCNT(j)  (256  + 64 * (j))
#define XB_XSUB(j)  (1280 + 64 * (j))
#define XB_XGEN(j)  (2304 + 64 * (j))
#define XB_TOP      3328
#define XB_TOPGEN   3392
#define XCD_BAR_WORDS 3456
#define XB_SPIN_CAP (1u << 18)

__device__ __forceinline__ unsigned xb_ld(unsigned* p)              { return __hip_atomic_load(p, __ATOMIC_RELAXED, __HIP_MEMORY_SCOPE_AGENT); }
__device__ __forceinline__ unsigned xb_add(unsigned* p, unsigned v) { return __hip_atomic_fetch_add(p, v, __ATOMIC_RELAXED, __HIP_MEMORY_SCOPE_AGENT); }
__device__ __forceinline__ unsigned xb_xcc_id() { return (unsigned)__builtin_amdgcn_s_getreg((3 << 11) | 20) & 0xFu; }
#define XB_SPIN(cond, bar) do { unsigned _sp = 0; while (cond) { __builtin_amdgcn_s_sleep(1); \
    if ((++_sp & 255u) == 0u) { if (xb_ld(&(bar)[XB_TMO])) break; if (_sp > XB_SPIN_CAP) { atomicAdd(&(bar)[XB_TMO], 1u); break; } } } } while (0)

struct XcdBarrier {
    unsigned* bar; unsigned x;
    volatile LAS unsigned* st;
};

__device__ __forceinline__ XcdBarrier xcd_barrier_post(unsigned* bar, volatile LAS unsigned* st) {
    XcdBarrier b; b.bar = bar; b.x = xb_xcc_id(); b.st = st;
    if (threadIdx.x == 0) (void)xb_add(&bar[XB_XCNT(b.x)], 1u);
    return b;
}
__device__ __forceinline__ void xcd_barrier_complete(unsigned* bar, unsigned x, unsigned& nloc, unsigned& nx) {
    const unsigned G = gridDim.x * gridDim.y * gridDim.z;
    unsigned sum, cnt, mine, sp = 0u;
    for (;;) {
        sum = 0u; cnt = 0u; mine = 0u;
#pragma unroll
        for (unsigned j = 0; j < 16; ++j) { const unsigned c = xb_ld(&bar[XB_XCNT(j)]); sum += c; cnt += (c > 0u) ? 1u : 0u; mine = (j == x) ? c : mine; }
        if (sum == G) break;
        __builtin_amdgcn_s_sleep(1);
        if ((++sp & 255u) == 0u) { if (xb_ld(&bar[XB_TMO])) break; if (sp > XB_SPIN_CAP) { atomicAdd(&bar[XB_TMO], 1u); break; } }
    }
    nloc = mine > 0u ? mine : 1u; nx = cnt > 0u ? cnt : 1u;
}

__device__ __forceinline__ void xcd_barrier(const XcdBarrier& b) {
    asm volatile("s_waitcnt vmcnt(0)" ::: "memory");
    __syncthreads();
    if (threadIdx.x == 0) {
        unsigned* bar = b.bar;
        __builtin_amdgcn_s_waitcnt(0);
        unsigned nloc = b.st[0], nx = b.st[1];
        if (nloc == 0u) { xcd_barrier_complete(bar, b.x, nloc, nx); b.st[0] = nloc; b.st[1] = nx; }
        const unsigned old = xb_add(&bar[XB_XSUB(b.x)], 1u);
        const unsigned gen = old / nloc;
        if (old + 1u == (gen + 1u) * nloc) {
            __builtin_amdgcn_fence(__ATOMIC_RELEASE, "agent");
            asm volatile("s_waitcnt vmcnt(0)" ::: "memory");
            const unsigned og = xb_add(&bar[XB_TOP], 1u);
            const unsigned tg = og / nx;
            if (og + 1u == (tg + 1u) * nx) xb_add(&bar[XB_TOPGEN], 1u);
            else XB_SPIN(xb_ld(&bar[XB_TOPGEN]) == tg, bar);
            __builtin_amdgcn_fence(__ATOMIC_ACQUIRE, "agent");
            xb_add(&bar[XB_XGEN(b.x)], 1u);
            asm volatile("s_waitcnt vmcnt(0)" ::: "memory");
        } else {
            XB_SPIN(xb_ld(&bar[XB_XGEN(b.x)]) == gen, bar);
            __builtin_amdgcn_fence(__ATOMIC_ACQUIRE, "agent");
            asm volatile("s_waitcnt vmcnt(0)" ::: "memory");
        }
    }
    __syncthreads();
}
struct Frame {
    LAS unsigned char* lds;
    volatile LAS unsigned* MISC;
    gu32* ctl;
    int tid, lane, wave;
    int vcu, G;
    unsigned char* ws;
    const float* x_in; const int* positions; const float* norm_g;
    const float *ffn_wg, *ffn_wu, *ffn_wd;
    const float *mla_wa, *mla_qag, *mla_kvag, *mla_wuq, *mla_wukv, *mla_qg, *mla_kg, *mla_wo;
    const float *swa_wqkv, *swa_qg, *swa_kg, *swa_sink, *swa_wo;
    float* out;
};

__device__ __forceinline__ float wave_sum(float v) {
#pragma unroll
    for (int o = 1; o < 64; o <<= 1) v += __shfl_xor(v, o);
    return v;
}
__device__ __forceinline__ float sum16(float v) {
#pragma unroll
    for (int o = 1; o < 16; o <<= 1) v += __shfl_xor(v, o);
    return v;
}
__device__ __forceinline__ float bf2f_u(unsigned short x) { return __uint_as_float(((unsigned)x) << 16); }

__device__ __forceinline__ void transpose_item(const float* W, int K, int N, bf16* WT, int mode, LAS float* scr, int item, int lane) {
    const int nblk = N / 32, kb = item / nblk, nb = item % nblk, k0 = 64 * kb, n0 = 32 * nb;
    const int drow0 = (mode == 0) ? n0 : ((n0 >> 7) * 256 + (mode - 1) * 128 + (n0 & 127));
#pragma unroll 8
    for (int i = 0; i < 32; ++i) { const int kk = 2 * i + (lane >> 5); scr[kk * 33 + (lane & 31)] = W[(size_t)(k0 + kk) * N + n0 + (lane & 31)]; }
    LDS_WAIT(); asm volatile("" ::: "memory");
    const int c = lane & 7;
#pragma unroll
    for (int j = 0; j < 4; ++j) { const int n = (lane >> 3) + 8 * j; const LAS float* s = scr + (8 * c) * 33 + n;
        v4u o; o.x = pk2(s[0 * 33], s[1 * 33]); o.y = pk2(s[2 * 33], s[3 * 33]); o.z = pk2(s[4 * 33], s[5 * 33]); o.w = pk2(s[6 * 33], s[7 * 33]);
        *(GAS v4u*)(WT + (size_t)(drow0 + n) * K + k0 + 8 * c) = o; }
    LDS_WAIT(); asm volatile("" ::: "memory");
}

__device__ __forceinline__ void transpose_item64(const float* W, int K, int N, bf16* WT, int mode, LAS unsigned char* scr, int item, int lane, const float* gk = nullptr) {
    const int nblk = N / 64, kb = item / nblk, nb = item % nblk, k0 = 64 * kb, n0 = 64 * nb;
    const int drow0 = (mode == 0) ? n0 : ((n0 >> 7) * 256 + (mode - 1) * 128 + (n0 & 127));
    const int p = lane & 15, q = lane >> 4;
    const float* wp = W + (size_t)(k0 + 2 * q) * N + n0 + 4 * p;
    f32x4 a[8], b[8];
#pragma unroll
    for (int i = 0; i < 8; ++i) { a[i] = __builtin_nontemporal_load((const f32x4*)(wp + (size_t)(8 * i) * N)); b[i] = __builtin_nontemporal_load((const f32x4*)(wp + (size_t)(8 * i + 1) * N)); }
    if (gk) {
#pragma unroll
        for (int i = 0; i < 8; ++i) { const pg8::f32x2 gg = *(const pg8::f32x2*)(gk + k0 + 8 * i + 2 * q); a[i] = a[i] * gg[0]; b[i] = b[i] * gg[1]; } }
#pragma unroll
    for (int i = 0; i < 8; ++i)
#pragma unroll
        for (int e = 0; e < 4; ++e) *(LAS unsigned*)(scr + (4 * p + e) * 132 + 2 * (8 * i + 2 * q)) = pg8::cvt_pk_bf16(a[i][e], b[i][e]);
    LDS_WAIT(); asm volatile("" ::: "memory");
    const int c = lane & 7;
#pragma unroll
    for (int j = 0; j < 8; ++j) { const int n = (lane >> 3) + 8 * j; const LAS unsigned* s = (const LAS unsigned*)(scr + n * 132 + 16 * c);
        v4u o; o.x = s[0]; o.y = s[1]; o.z = s[2]; o.w = s[3];
        *(GAS v4u*)(WT + (size_t)(drow0 + n) * K + k0 + 8 * c) = o; }
    LDS_WAIT(); asm volatile("" ::: "memory");
}

constexpr int I_GU = (DM / 64) * (DFF / 64), I_D = (DFF / 64) * (DM / 64), I_FFN = 2 * I_GU + I_D;
constexpr int I_A = (DM / 64) * (MLA_NA / 64), I_UQ = (MLA_R / 64) * (MLA_NQ / 64), I_UKV = (MLA_R / 64) * (MLA_NKV / 64), I_O = (DM / 64) * (DM / 64), I_MLA = I_A + I_UQ + I_UKV + I_O;
constexpr int I_QKV = (DM / 64) * (SWA_NQKV / 64), I_SWA = I_QKV + I_O;
__host__ __device__ constexpr int layer_items(int L) { return 2 * I_FFN + ((L & 1) ? I_SWA : I_MLA); }
__device__ __forceinline__ void convert_layer_item(Frame& F, int L, int r, LAS unsigned char* scr) {
    if (r < 2 * I_FFN) { const int f = 2 * L + r / I_FFN; r %= I_FFN;
        bf16* wgu = (bf16*)(F.ws + WS_WFFN + (size_t)f * FFN_STRIDE); bf16* wd = (bf16*)(F.ws + WS_WFFN + (size_t)f * FFN_STRIDE + FFN_WD_OFF);
        if (r < I_GU) { transpose_item64(F.ffn_wg + (size_t)f * DM * DFF, DM, DFF, wgu, 1, scr, r, F.lane); return; } r -= I_GU;
        if (r < I_GU) { transpose_item64(F.ffn_wu + (size_t)f * DM * DFF, DM, DFF, wgu, 2, scr, r, F.lane); return; } r -= I_GU;
        transpose_item64(F.ffn_wd + (size_t)f * DFF * DM, DFF, DM, wd, 0, scr, r, F.lane); return; }
    r -= 2 * I_FFN; const int j = L >> 1;
    if ((L & 1) == 0) { unsigned char* wb = F.ws + WS_WMLA + (size_t)j * MLA_STRIDE;
        if (r < I_A) { transpose_item64(F.mla_wa + (size_t)j * DM * MLA_NA, DM, MLA_NA, (bf16*)wb, 0, scr, r, F.lane); return; } r -= I_A;
        if (r < I_UQ) { transpose_item64(F.mla_wuq + (size_t)j * MLA_R * MLA_NQ, MLA_R, MLA_NQ, (bf16*)(wb + MLA_WUQ_OFF), 0, scr, r, F.lane, F.mla_qag + j * MLA_R); return; } r -= I_UQ;
        if (r < I_UKV) { transpose_item64(F.mla_wukv + (size_t)j * MLA_R * MLA_NKV, MLA_R, MLA_NKV, (bf16*)(wb + MLA_WUKV_OFF), 0, scr, r, F.lane, F.mla_kvag + j * MLA_R); return; } r -= I_UKV;
        transpose_item64(F.mla_wo + (size_t)j * DM * DM, DM, DM, (bf16*)(wb + MLA_WO_OFF), 0, scr, r, F.lane); return; }
    { unsigned char* wb = F.ws + WS_WSWA + (size_t)j * SWA_STRIDE;
        if (r < I_QKV) { transpose_item64(F.swa_wqkv + (size_t)j * DM * SWA_NQKV, DM, SWA_NQKV, (bf16*)wb, 0, scr, r, F.lane); return; } r -= I_QKV;
        transpose_item64(F.swa_wo + (size_t)j * DM * DM, DM, DM, (bf16*)(wb + SWA_WO_OFF), 0, scr, r, F.lane); }
}
#ifndef TAIL_NA
#define TAIL_NA 48
#endif
#ifndef TAIL_NC
#define TAIL_NC 48
#endif
#ifndef TAIL_NB_M
#define TAIL_NB_M 72
#endif
#ifndef TAIL_NB_S
#define TAIL_NB_S 48
#endif
__host__ __device__ constexpr int mix_items(int L) { return (L & 1) ? I_SWA : I_MLA; }
__host__ __device__ constexpr int stream_len(int L) { return I_FFN + (L < 3 ? I_FFN + mix_items(L + 1) : 0); }
__host__ __device__ constexpr int tail_b_items(int L) { return (L & 1) ? 128 * TAIL_NB_S : 96 * TAIL_NB_M; }
__host__ __device__ constexpr int tail_cap(int L) { return 128 * TAIL_NA + tail_b_items(L) + 128 * TAIL_NC; }
__host__ __device__ constexpr int tail_covered(int L) { return tail_cap(L) < stream_len(L) ? tail_cap(L) : stream_len(L); }
static_assert(128 * TAIL_NA + tail_b_items(0) >= I_FFN && 128 * TAIL_NA + tail_b_items(1) >= I_FFN, "slots A + B must cover the layer's own post-FFN weights");
__device__ __forceinline__ void convert_stream_entry(Frame& F, int L, int r, LAS unsigned char* scr) {
    if (r < I_FFN) convert_layer_item(F, L, I_FFN + r, scr);
    else convert_layer_item(F, L + 1, r < 2 * I_FFN ? r - I_FFN : r, scr);
}
__device__ __forceinline__ void tail_convert(Frame& F, int L, int slot) {
    if (F.G != 256) return;
    const int c = (int)blockIdx.x; int first_idle = 128, per = TAIL_NA, base = 0;
    if (slot == 1) { base = 128 * TAIL_NA; if (L & 1) { per = TAIL_NB_S; } else { first_idle = 160; per = TAIL_NB_M; } }
    else if (slot == 2) { base = 128 * TAIL_NA + tail_b_items(L); per = TAIL_NC; }
    if (c < first_idle) return;
    LAS unsigned char* scr = F.lds + RING_OFF + F.wave * 16384;
    const int start = base + (c - first_idle) * per, n = stream_len(L);
    for (int r = start + F.wave; r < start + per && r < n; r += NWAVES) convert_stream_entry(F, L, r, scr);
}

__device__ __forceinline__ void p_prologue(Frame& F) {
    LAS unsigned char* scr = F.lds + RING_OFF + F.wave * 16384;
    const int gw = F.vcu * NWAVES + F.wave, NGW = F.G * NWAVES;
    const bool tails = (F.G == 256);
    const int c0 = tails ? tail_covered(0) : 0, c1 = tails ? tail_covered(1) : 0, c2 = tails ? tail_covered(2) : 0, c3 = tails ? tail_covered(3) : 0;
    const int n0 = I_FFN + I_MLA, r0 = stream_len(0) - c0, r1 = stream_len(1) - c1, r2 = stream_len(2) - c2, r3 = stream_len(3) - c3;
    for (int it = gw; it < n0 + r0 + r1 + r2 + r3; it += NGW) {
        int r = it;
        if (r < n0) { convert_layer_item(F, 0, r < I_FFN ? r : I_FFN + r, scr); continue; } r -= n0;
        if (r < r0) { convert_stream_entry(F, 0, c0 + r, scr); continue; } r -= r0;
        if (r < r1) { convert_stream_entry(F, 1, c1 + r, scr); continue; } r -= r1;
        if (r < r2) { convert_stream_entry(F, 2, c2 + r, scr); continue; } r -= r2;
        convert_stream_entry(F, 3, c3 + r, scr);
    }
    { const int gt = F.vcu * (NWAVES * 64) + F.tid, NGT = F.G * NWAVES * 64;
      for (int i = gt; i < 2 * 49152; i += NGT) { const int j = i / 49152, r = i % 49152;
          *(GAS v4u*)(F.ws + WS_WMLA + (size_t)j * MLA_STRIDE + (size_t)MLA_NA * DM * 2 + (size_t)r * 16) = (v4u){0u, 0u, 0u, 0u}; }
      float* COS = (float*)(F.ws + WS_COS); float* SIN = (float*)(F.ws + WS_SIN);
      for (int i = gt; i < S_ * 32; i += NGT) { const int t = i >> 5, j = i & 31;
          const float inv_freq = 1.0f / powf(10000.0f, (float)(2 * j) * (1.0f / 64.0f));
          const float ang = (float)F.positions[t] * inv_freq;
          const double turns = (double)ang * 0.15915494309189533577; const double fr = turns - rint(turns);
          const float frf = (float)fr;
          COS[i] = __builtin_amdgcn_cosf(frf); SIN[i] = __builtin_amdgcn_sinf(frf); }
    }
}

typedef _Float16 f16x4_t __attribute__((ext_vector_type(4)));
template <bool XH> __device__ __forceinline__ void p_norm(Frame& F, const void* x, const float* g, bf16* xn) {
    const int gw = F.vcu * NWAVES + F.wave, NGW = F.G * NWAVES;
    f32x4 gv[8];
#pragma unroll
    for (int j = 0; j < 8; ++j) gv[j] = ((const GAS f32x4*)g)[F.lane + 64 * j];
    for (int m = gw; m < S_; m += NGW) {
        f32x4 v[8]; float s2 = 0.f;
        if (XH) { const GAS f16x4_t* xr = (const GAS f16x4_t*)((const _Float16*)x + (size_t)m * DM) + F.lane;
#pragma unroll
            for (int j = 0; j < 8; ++j) { const f16x4_t h = xr[64 * j]; v[j] = (f32x4){(float)h[0], (float)h[1], (float)h[2], (float)h[3]}; } }
        else { const GAS f32x4* xr = (const GAS f32x4*)((const float*)x + (size_t)m * DM) + F.lane;
#pragma unroll
            for (int j = 0; j < 8; ++j) v[j] = xr[64 * j]; }
#pragma unroll
        for (int j = 0; j < 8; ++j) s2 += (v[j].x * v[j].x + v[j].y * v[j].y) + (v[j].z * v[j].z + v[j].w * v[j].w);
        const float rstd = 1.0f / sqrtf(wave_sum(s2) * (1.f / DM) + RMS_EPS);
        GAS unsigned long long* o8 = (GAS unsigned long long*)(xn + (size_t)m * DM) + F.lane;
#pragma unroll
        for (int j = 0; j < 8; ++j) { const f32x4 y = v[j] * rstd * gv[j]; o8[64 * j] = (unsigned long long)pk2(y.x, y.y) | ((unsigned long long)pk2(y.z, y.w) << 32); }
    }
}

__device__ __forceinline__ void p_mla_mid(Frame& F, const float* H, const float* qag, const float* kvag, bf16* cqn, bf16* ckvn) {
    const int gw = F.vcu * NWAVES + F.wave, NGW = F.G * NWAVES;
    const f32x4 ga0 = ((const GAS f32x4*)qag)[F.lane], ga1 = ((const GAS f32x4*)qag)[64 + F.lane], gb0 = ((const GAS f32x4*)kvag)[F.lane], gb1 = ((const GAS f32x4*)kvag)[64 + F.lane];
    for (int m = gw; m < S_; m += NGW) {
        const GAS f32x4* hr = (const GAS f32x4*)(H + (size_t)m * MLA_NA_PAD) + F.lane;
        const f32x4 a0 = hr[0], a1 = hr[64], b0 = hr[128], b1 = hr[192];
        const float sa = wave_sum((a0.x * a0.x + a0.y * a0.y) + (a0.z * a0.z + a0.w * a0.w) + (a1.x * a1.x + a1.y * a1.y) + (a1.z * a1.z + a1.w * a1.w));
        const float sb = wave_sum((b0.x * b0.x + b0.y * b0.y) + (b0.z * b0.z + b0.w * b0.w) + (b1.x * b1.x + b1.y * b1.y) + (b1.z * b1.z + b1.w * b1.w));
        const float ra = 1.0f / sqrtf(sa * (1.f / 512.f) + RMS_EPS), rb = 1.0f / sqrtf(sb * (1.f / 512.f) + RMS_EPS);
        GAS unsigned long long* oa = (GAS unsigned long long*)(cqn + (size_t)m * MLA_R) + F.lane; GAS unsigned long long* ob = (GAS unsigned long long*)(ckvn + (size_t)m * MLA_R) + F.lane;
        { const f32x4 y = a0 * ra * ga0; oa[0] = (unsigned long long)pk2(y.x, y.y) | ((unsigned long long)pk2(y.z, y.w) << 32); }
        { const f32x4 y = a1 * ra * ga1; oa[64] = (unsigned long long)pk2(y.x, y.y) | ((unsigned long long)pk2(y.z, y.w) << 32); }
        { const f32x4 y = b0 * rb * gb0; ob[0] = (unsigned long long)pk2(y.x, y.y) | ((unsigned long long)pk2(y.z, y.w) << 32); }
        { const f32x4 y = b1 * rb * gb1; ob[64] = (unsigned long long)pk2(y.x, y.y) | ((unsigned long long)pk2(y.z, y.w) << 32); }
    }
}

struct KPrepIn { v4u kn[4]; float c0, c1, s0, s1, ka0, ka1, kb0, kb1; };
__device__ __forceinline__ void p_mla_prep(Frame& F, const bf16* __restrict__ KV, const float* __restrict__ H, const float* __restrict__ kg, bf16* __restrict__ KN) {
    const int gw = F.vcu * NWAVES + F.wave, NGW = F.G * NWAVES; const int i16 = F.lane & 15, hsub = F.lane >> 4;
    const float* COS = (const float*)(F.ws + WS_COS); const float* SIN = (const float*)(F.ws + WS_SIN);
    const f32x4 kg0 = *(const f32x4*)(kg + 8 * i16), kg1 = *(const f32x4*)(kg + 8 * i16 + 4);
    const float kgr[4] = {kg[128 + 2 * i16], kg[129 + 2 * i16], kg[160 + 2 * i16], kg[161 + 2 * i16]};
    auto load = [&](int t, KPrepIn& in) {
        in.c0 = COS[t * 32 + 2 * i16]; in.c1 = COS[t * 32 + 2 * i16 + 1]; in.s0 = SIN[t * 32 + 2 * i16]; in.s1 = SIN[t * 32 + 2 * i16 + 1];
        const float* kpe = H + (size_t)t * 64;
        in.ka0 = kpe[2 * i16]; in.ka1 = kpe[2 * i16 + 1]; in.kb0 = kpe[32 + 2 * i16]; in.kb1 = kpe[33 + 2 * i16];
#pragma unroll
        for (int pass = 0; pass < 4; ++pass) in.kn[pass] = *(const GAS v4u*)(KV + (size_t)t * MLA_NKV + (pass * 4 + hsub) * 256 + 8 * i16); };
    auto finish = [&](int t, const KPrepIn& in) {
        const float ss_pe = sum16((in.ka0 * in.ka0 + in.ka1 * in.ka1) + (in.kb0 * in.kb0 + in.kb1 * in.kb1));
        const float px0 = in.ka0 * kgr[0], px1 = in.ka1 * kgr[1], py0 = in.kb0 * kgr[2], py1 = in.kb1 * kgr[3];
        const float rx0 = px0 * in.c0 - py0 * in.s0, rx1 = px1 * in.c1 - py1 * in.s1, ry0 = py0 * in.c0 + px0 * in.s0, ry1 = py1 * in.c1 + px1 * in.s1;
#pragma unroll
        for (int pass = 0; pass < 4; ++pass) { const int h = pass * 4 + hsub; const v4u kn = in.kn[pass];
            float kf[8] = {bf2f_u((unsigned short)kn.x), bf2f_u((unsigned short)(kn.x >> 16)), bf2f_u((unsigned short)kn.y), bf2f_u((unsigned short)(kn.y >> 16)),
                           bf2f_u((unsigned short)kn.z), bf2f_u((unsigned short)(kn.z >> 16)), bf2f_u((unsigned short)kn.w), bf2f_u((unsigned short)(kn.w >> 16))};
            float sk = 0.f;
#pragma unroll
            for (int e = 0; e < 8; ++e) sk += kf[e] * kf[e];
            const float rk = 1.0f / sqrtf((sum16(sk) + ss_pe) * (1.f / 192.f) + RMS_EPS);
            bf16* kp = KN + (size_t)t * MLA_NQ + h * 192;
            { v4u o; o.x = pk2(kf[0] * rk * kg0.x, kf[1] * rk * kg0.y); o.y = pk2(kf[2] * rk * kg0.z, kf[3] * rk * kg0.w); o.z = pk2(kf[4] * rk * kg1.x, kf[5] * rk * kg1.y); o.w = pk2(kf[6] * rk * kg1.z, kf[7] * rk * kg1.w);
              *(GAS v4u*)(kp + 8 * i16) = o; }
            *(GAS unsigned*)(kp + 128 + 2 * i16) = pk2(rx0 * rk, rx1 * rk); *(GAS unsigned*)(kp + 160 + 2 * i16) = pk2(ry0 * rk, ry1 * rk);
        } };
    int t0 = gw; if (t0 >= S_) return;
    KPrepIn A, B; load(t0, A);
    for (;;) {
        const int t1 = t0 + NGW; const bool h1 = t1 < S_;
        if (h1) load(t1, B);
        finish(t0, A);
        if (!h1) break;
        t0 = t1 + NGW; const bool h0 = t0 < S_;
        if (h0) load(t0, A);
        finish(t1, B);
        if (!h0) break;
    }
}

struct Ctx { int pid, lo, hi; XcdBarrier bar; };
#define PH_ON() (C.pid >= C.lo && C.pid < C.hi)
#define PH_END() do { if (C.pid >= C.lo && C.pid + 1 < C.hi) xcd_barrier(C.bar); ++C.pid; } while (0)
#define WS_PTRS() bf16* XN = (bf16*)(F.ws + WS_XN); bf16* ACT = (bf16*)(F.ws + WS_ACT); float* SSA = (float*)(F.ws + WS_SSA); float* KPE = (float*)(F.ws + WS_KPE); const LAS float* RSTAB = (const LAS float*)(F.lds + RSTAB_OFF); \
    bf16* CQN = (bf16*)(F.ws + WS_CQN); bf16* CKVN = (bf16*)(F.ws + WS_CKVN); bf16* Q = (bf16*)(F.ws + WS_Q); bf16* KV = (bf16*)(F.ws + WS_KV); bf16* KN = (bf16*)(F.ws + WS_KN); bf16* OB = (bf16*)(F.ws + WS_O); _Float16* XS = (_Float16*)(F.ws + WS_XS); \
    (void)XN; (void)ACT; (void)SSA; (void)KPE; (void)RSTAB; (void)CQN; (void)CKVN; (void)Q; (void)KV; (void)KN; (void)OB; (void)XS

template <int NSLOTS> __device__ __forceinline__ void build_rstd(Frame& F, const pg8::StaticOrder& So, const float* ss, int ld, int slot0, float inv_n) {
    pg8::Unit u0; const bool any = So.next(0, u0);
    if (any) { LAS float* tab = (LAS float*)(F.lds + RSTAB_OFF); const int g = u0.pm >> 3;
#pragma unroll
        for (int k = 0; k < 4; ++k) { const int r = F.tid + 512 * k; const float* p = ss + (size_t)(g * 2048 + r) * ld + slot0; float s = 0.f;
#pragma unroll
            for (int q4 = 0; q4 < NSLOTS / 4; ++q4) { const f32x4 v = *(const f32x4*)(p + 4 * q4); s += (v.x + v.y) + (v.z + v.w); }
            tab[r] = __builtin_amdgcn_rsqf(s * inv_n + RMS_EPS); } }
    __syncthreads();
}

__device__ __forceinline__ void ffn_block(Frame& F, Ctx& C, int L, int part) {
    WS_PTRS();
    const float* gL = F.norm_g + (size_t)L * 3 * DM;
    const int f = L * 2 + (part >> 1);
    const bool first = (L == 0 && part == 0), last = (L == DEPTH - 1 && part == 2);
    if (!first) { if (PH_ON()) p_norm<true>(F, XS, gL + part * DM, XN); PH_END(); }
    if (PH_ON()) { pg8::Gemm g{XN, (const bf16*)(F.ws + WS_WFFN + (size_t)f * FFN_STRIDE), S_, 2 * DFF, DM}; pg8::StaticOrder So; So.init(S_, 2 * DFF, F.G, (int)blockIdx.x);
        pg8::EpiSwiGLU E{ACT, DFF};
        pg8::gemm_phase<pg8::EpiSwiGLU, pg8::StaticOrder, true, true>(F.lds + RING_OFF, g, So, E);
        if (PROBE_REP & 2) pg8::gemm_phase<pg8::EpiSwiGLU, pg8::StaticOrder, true, true>(F.lds + RING_OFF, g, So, E);
        tail_convert(F, L, part); }
    PH_END();
    if (PH_ON()) { pg8::Gemm g{ACT, (const bf16*)(F.ws + WS_WFFN + (size_t)f * FFN_STRIDE + FFN_WD_OFF), S_, DM, DFF}; pg8::StaticOrder So; So.init(S_, DM, F.G, (int)blockIdx.x);
        if (first) { pg8::EpiResid<false, true> E{F.x_in, XS, DM, 0.5f}; pg8::gemm_phase<pg8::EpiResid<false, true>, pg8::StaticOrder, true, true>(F.lds + RING_OFF, g, So, E); }
        else if (last) { pg8::EpiResid<true, false> E{XS, F.out, DM, 0.5f}; pg8::gemm_phase<pg8::EpiResid<true, false>, pg8::StaticOrder, true, true>(F.lds + RING_OFF, g, So, E); }
        else { pg8::EpiResid<true, true> E{XS, XS, DM, 0.5f}; pg8::gemm_phase<pg8::EpiResid<true, true>, pg8::StaticOrder, true, true>(F.lds + RING_OFF, g, So, E); } }
    PH_END();
}
__device__ __forceinline__ void mla_block(Frame& F, Ctx& C, int L) {
    WS_PTRS();
    const float* gL = F.norm_g + (size_t)L * 3 * DM;
    const int j = L >> 1; unsigned char* wb = F.ws + WS_WMLA + (size_t)j * MLA_STRIDE;
    if (PH_ON()) p_norm<true>(F, XS, gL + DM, XN);
    PH_END();
    if (PH_ON()) { pg8::Gemm g{XN, (const bf16*)wb, S_, MLA_NA_PAD, DM}; pg8::StaticOrder So; So.init(S_, MLA_NA_PAD, F.G, (int)blockIdx.x);
        pg8::EpiMlaA E{CQN, CKVN, KPE, SSA};
        pg8::gemm_phase<pg8::EpiMlaA, pg8::StaticOrder, true, true>(F.lds + RING_OFF, g, So, E);
        tail_convert(F, L, 1); }
    PH_END();
    if (PH_ON()) {
        { pg8::Gemm g{CQN, (const bf16*)(wb + MLA_WUQ_OFF), S_, MLA_NQ, MLA_R}; pg8::StaticOrder So; So.init(S_, MLA_NQ, F.G, (int)blockIdx.x);
          build_rstd<8>(F, So, SSA, 16, 0, 1.0f / MLA_R);
          pg8::EpiBf16R E{Q, MLA_NQ, RSTAB};
          pg8::gemm_phase<pg8::EpiBf16R, pg8::StaticOrder, true, true>(F.lds + RING_OFF, g, So, E); }
        { pg8::Gemm g{CKVN, (const bf16*)(wb + MLA_WUKV_OFF), S_, MLA_NKV, MLA_R}; pg8::StaticOrder So; So.init(S_, MLA_NKV, F.G, (int)blockIdx.x);
          build_rstd<8>(F, So, SSA, 16, 8, 1.0f / MLA_R);
          pg8::EpiBf16R E{KV, MLA_NKV, RSTAB};
          pg8::gemm_phase<pg8::EpiBf16R, pg8::StaticOrder, true, true>(F.lds + RING_OFF, g, So, E); }
    }
    PH_END();
    if (PH_ON()) p_mla_prep(F, KV, KPE, F.mla_kg + j * 192, KN);
    PH_END();
    if (PH_ON()) {
        for (int u = F.vcu; u < 16 * 32; u += F.G) { if (!att::mla::unit_fixed<0>(F.lds + RING_OFF, (LAS float*)(F.lds + WSCR_OFF), Q, KN, KV, OB, u >> 5, u & 31, F.mla_qg + j * 192, (const float*)(F.ws + WS_COS), (const float*)(F.ws + WS_SIN)) || FIXED_FORCE_FALLBACK)
            att::mla::unit_softn<0>(F.lds + RING_OFF, (LAS float*)(F.lds + WSCR_OFF), Q, KN, KV, OB, u >> 5, u & 31, F.mla_qg + j * 192, (const float*)(F.ws + WS_COS), (const float*)(F.ws + WS_SIN)); }
        if (PROBE_REP & 4) for (int u = F.vcu; u < 16 * 32; u += F.G) att::mla::MLA_UNIT<PROBE_MODE>(F.lds + RING_OFF, (LAS float*)(F.lds + WSCR_OFF), Q, KN, KV, (bf16*)(F.ws + WS_END), u >> 5, u & 31, F.mla_qg + j * 192, (const float*)(F.ws + WS_COS), (const float*)(F.ws + WS_SIN));
    }
    PH_END();
    if (PH_ON()) { pg8::Gemm g{OB, (const bf16*)(wb + MLA_WO_OFF), S_, DM, DM}; pg8::StaticOrder So; So.init(S_, DM, F.G, (int)blockIdx.x);
        pg8::EpiResid<true, true> E{XS, XS, DM, 1.0f};
        pg8::gemm_phase<pg8::EpiResid<true, true>, pg8::StaticOrder, true, true>(F.lds + RING_OFF, g, So, E); }
    PH_END();
}
__device__ __forceinline__ void swa_block(Frame& F, Ctx& C, int L) {
    WS_PTRS();
    const float* gL = F.norm_g + (size_t)L * 3 * DM;
    const int j = L >> 1; unsigned char* wb = F.ws + WS_WSWA + (size_t)j * SWA_STRIDE;
    if (PH_ON()) p_norm<true>(F, XS, gL + DM, XN);
    PH_END();
    if (PH_ON()) { pg8::Gemm g{XN, (const bf16*)wb, S_, SWA_NQKV, DM}; pg8::StaticOrder So; So.init(S_, SWA_NQKV, F.G, (int)blockIdx.x);
        pg8::EpiBf16<0> E{Q, SWA_NQKV, nullptr, 0, 0, 1.f};
        pg8::gemm_phase<pg8::EpiBf16<0>, pg8::StaticOrder, true, true>(F.lds + RING_OFF, g, So, E);
        if (PROBE_REP & 2048) pg8::gemm_phase<pg8::EpiBf16<0>, pg8::StaticOrder, true, true>(F.lds + RING_OFF, g, So, E);
        tail_convert(F, L, 1); }
    PH_END();
    if (PH_ON()) {
        for (int rep = 0; rep < ((PROBE_REP & 16) ? 2 : 1); ++rep) for (int u = F.vcu; u < 8 * 32; u += F.G)
            att::swa::super_unit(F.lds + RING_OFF, (LAS float*)(F.lds + POSK_OFF), (LAS float*)(F.lds + WSCR_OFF), F.lds + RSTAB_OFF, Q, F.positions, F.swa_qg + j * 64, F.swa_kg + j * 64, F.swa_sink + j * 32, OB, u >> 5, u & 31);
    }
    PH_END();
    if (PH_ON()) { pg8::Gemm g{OB, (const bf16*)(wb + SWA_WO_OFF), S_, DM, DM}; pg8::StaticOrder So; So.init(S_, DM, F.G, (int)blockIdx.x);
        pg8::EpiResid<true, true> E{XS, XS, DM, 1.0f};
        pg8::gemm_phase<pg8::EpiResid<true, true>, pg8::StaticOrder, true, true>(F.lds + RING_OFF, g, So, E); }
    PH_END();
}

struct Args { const void* in[19]; float* out; unsigned char* ws; int ph_lo, ph_hi; };
__global__ void __launch_bounds__(NWAVES * 64, 2) mk_fwd(Args args) {
    extern __shared__ __attribute__((aligned(16))) unsigned char lds[];
    Frame F;
    F.lds = (LAS unsigned char*)lds;
    F.MISC = (volatile LAS unsigned*)(F.lds + MISC_OFF);
    F.tid = threadIdx.x; F.lane = F.tid & 63; F.wave = __builtin_amdgcn_readfirstlane(F.tid >> 6);
    F.G = gridDim.x; { const int bx = blockIdx.x; F.vcu = (F.G % 8 == 0) ? (bx % 8) * (F.G / 8) + bx / 8 : bx; }
    F.ws = args.ws; F.ctl = (gu32*)(args.ws + WS_CTL);
    F.x_in = (const float*)args.in[0]; F.positions = (const int*)args.in[1]; F.norm_g = (const float*)args.in[2];
    F.ffn_wg = (const float*)args.in[3]; F.ffn_wu = (const float*)args.in[4]; F.ffn_wd = (const float*)args.in[5];
    F.mla_wa = (const float*)args.in[6]; F.mla_qag = (const float*)args.in[7]; F.mla_kvag = (const float*)args.in[8]; F.mla_wuq = (const float*)args.in[9]; F.mla_wukv = (const float*)args.in[10];
    F.mla_qg = (const float*)args.in[11]; F.mla_kg = (const float*)args.in[12]; F.mla_wo = (const float*)args.in[13];
    F.swa_wqkv = (const float*)args.in[14]; F.swa_qg = (const float*)args.in[15]; F.swa_kg = (const float*)args.in[16]; F.swa_sink = (const float*)args.in[17]; F.swa_wo = (const float*)args.in[18];
    F.out = args.out;
    for (int u = F.tid; u < (LDS_BYTES - LDSCTL_OFF) / 4; u += NWAVES * 64) ((LAS unsigned*)(F.lds + LDSCTL_OFF))[u] = 0u;
    __syncthreads();
    Ctx C; C.pid = 0; C.lo = args.ph_lo; C.hi = args.ph_hi;
    C.bar.bar = (unsigned*)(F.ctl + CW_BAR); C.bar.x = 0; C.bar.st = nullptr;
    if (!MK_PER_PHASE) C.bar = xcd_barrier_post((unsigned*)(F.ctl + CW_BAR), F.MISC + 8);

    if (PH_ON()) { p_prologue(F); p_norm<false>(F, F.x_in, F.norm_g, (bf16*)(F.ws + WS_XN)); if (PROBE_REP & 1) p_prologue(F); if (PROBE_REP & 64) { for (int rep = 0; rep < 20; ++rep) xcd_barrier(C.bar); } }
    PH_END();
#if TEST_PROG == 0
#pragma unroll 1
    for (int lp = 0; lp < 2; ++lp) {
        ffn_block(F, C, 2 * lp, 0); mla_block(F, C, 2 * lp); ffn_block(F, C, 2 * lp, 2);
        ffn_block(F, C, 2 * lp + 1, 0); swa_block(F, C, 2 * lp + 1); ffn_block(F, C, 2 * lp + 1, 2);
    }
#elif TEST_PROG == 6
    ffn_block(F, C, 0, 0); mla_block(F, C, 0); ffn_block(F, C, 0, 2);
    ffn_block(F, C, 1, 0); swa_block(F, C, 1); ffn_block(F, C, 1, 2);
    ffn_block(F, C, 2, 0); mla_block(F, C, 2); ffn_block(F, C, 2, 2);
    ffn_block(F, C, 3, 0); swa_block(F, C, 3); ffn_block(F, C, 3, 2);
#elif TEST_PROG == 1
    ffn_block(F, C, 0, 0);
#elif TEST_PROG == 2
    ffn_block(F, C, 0, 0); ffn_block(F, C, 0, 2);
#elif TEST_PROG == 3
    mla_block(F, C, 0);
#elif TEST_PROG == 4
    swa_block(F, C, 1);
#elif TEST_PROG == 5
    for (int lp = 0; lp < 2; ++lp) { ffn_block(F, C, 2 * lp, 0); }
#endif
}
#undef PH_ON
#undef PH_END
#undef WS_PTRS
constexpr int N_PHASES = 1 + 8 * 3 - 1 + 2 * 6 + 2 * 4;

extern "C" void kernel_launch(void* const* d_in, const int* in_sizes, int n_in, void* d_out, int out_size, void* d_ws, size_t ws_size, hipStream_t stream) {
    static int grid = 0;
    if (grid == 0) {
        if (n_in != 19 || in_sizes[0] != S_ * DM || out_size != S_ * DM || ws_size < WS_END) { fprintf(stderr, "kernel_launch: shape mismatch (n_in %d, in0 %d, out %d, ws %zu < %zu)\n", n_in, n_in > 0 ? in_sizes[0] : -1, out_size, ws_size, (size_t)WS_END); grid = -1; return; }
        int dev = 0, cus = 0, per_cu = 0;
        if (hipGetDevice(&dev) != hipSuccess || hipDeviceGetAttribute(&cus, hipDeviceAttributeMultiprocessorCount, dev) != hipSuccess) { fprintf(stderr, "kernel_launch: device query failed\n"); grid = -1; return; }
        if (hipFuncSetAttribute((const void*)mk_fwd, hipFuncAttributeMaxDynamicSharedMemorySize, LDS_BYTES) != hipSuccess) { fprintf(stderr, "kernel_launch: hipFuncSetAttribute failed\n"); grid = -1; return; }
        if (hipOccupancyMaxActiveBlocksPerMultiprocessor(&per_cu, (const void*)mk_fwd, NWAVES * 64, LDS_BYTES) != hipSuccess || per_cu < 1)
            fprintf(stderr, "kernel_launch: note: occupancy query reports %d workgroups per CU\n", per_cu);
        (void)hipGetLastError();
        grid = cus;
    }
    if (grid < 0) return;
    if (hipMemsetAsync((char*)d_ws + WS_CTL, 0, CTL_USED_BYTES, stream) != hipSuccess) { fprintf(stderr, "kernel_launch: memset failed\n"); return; }
    Args a{};
    for (int i = 0; i < 19; ++i) a.in[i] = d_in[i];
    a.out = (float*)d_out; a.ws = (unsigned char*)d_ws;
#if MK_PER_PHASE
    for (int p = 0; p < N_PHASES; ++p) { a.ph_lo = p; a.ph_hi = p + 1; hipLaunchKernelGGL(mk_fwd, dim3(grid), dim3(NWAVES * 64), LDS_BYTES, stream, a); }
#else
    a.ph_lo = 0; a.ph_hi = N_PHASES;
    hipLaunchKernelGGL(mk_fwd, dim3(grid), dim3(NWAVES * 64), LDS_BYTES, stream, a);
#endif
    const hipError_t le = hipPeekAtLastError();
    if (le != hipSuccess) fprintf(stderr, "kernel_launch: launch failed: %s\n", hipGetErrorName(le));
}
```
